# Optimizing an MI355X kernel written in HIP

```python
import jax, jax.numpy as jnp
from jax import lax
import numpy as np

D_MODEL = 1024
BATCH = 32
SEQ = 256
DEPTH = 1
DEC_BATCH = 4
DEC_SEQ = 1024
PAST_LEN = 512

GRID_W = 64
N_HEADS = 4
HEAD_K = 128
HEAD_V = 256
KEY_DIM = N_HEADS * HEAD_K
VAL_DIM = N_HEADS * HEAD_V
GATE_RANK = 16
GATE_NORMALIZER = 16.0
CHUNK = 64
CONV_DIM = D_MODEL
D_FF = 2816
N_MOD = 6
EPS = 1e-6
IN_SPLITS = (KEY_DIM, KEY_DIM, VAL_DIM, VAL_DIM, GATE_RANK, GATE_RANK,
             CONV_DIM, CONV_DIM, CONV_DIM, VAL_DIM, CONV_DIM)
IN_DIM = 2 * KEY_DIM + 3 * VAL_DIM + 2 * GATE_RANK + 4 * CONV_DIM

kernel_name = "bidir_gla_shortconv_convffn_prefix_dit"


def rmsnorm(x, g):
    xf = x.astype(jnp.float32)
    y = xf * lax.rsqrt(jnp.mean(xf * xf, axis=-1, keepdims=True) + EPS)
    return (y * g.astype(jnp.float32)).astype(x.dtype)


def split_cols(h):
    outs, off = [], 0
    for w in IN_SPLITS:
        outs.append(h[..., off:off + w])
        off += w
    return outs


def to_heads(t, hd):
    b, l, _ = t.shape
    return t.reshape(b, l, N_HEADS, hd).transpose(0, 2, 1, 3)


def short_conv1d(x, w):
    l = x.shape[1]
    xp = jnp.pad(x, ((0, 0), (1, 1), (0, 0)))
    return xp[:, :l] * w[0] + xp[:, 1:l + 1] * w[1] + xp[:, 2:] * w[2]


def dwconv3x3(x, w, b, rows, width):
    bn, l, f = x.shape
    img = x.reshape(bn, rows, width, f)
    out = lax.conv_general_dilated(img, w[:, :, None, :].astype(img.dtype), (1, 1), ((1, 1), (1, 1)),
                                   dimension_numbers=('NHWC', 'HWIO', 'NHWC'), feature_group_count=f)
    return out.reshape(bn, l, f) + b


def gla_chunked(q, k, v, g, s0):
    bn, h, l, dk = q.shape
    dv = v.shape[-1]
    n = l // CHUNK
    qc = q.reshape(bn, h, n, CHUNK, dk)
    kc = k.reshape(bn, h, n, CHUNK, dk)
    vc = v.reshape(bn, h, n, CHUNK, dv)
    bcum = jnp.cumsum(g.astype(jnp.float32).reshape(bn, h, n, CHUNK, dk), axis=3)
    b_last = bcum[:, :, :, -1:, :]
    b_ref = bcum[:, :, :, CHUNK // 2:CHUNK // 2 + 1, :]
    a = jnp.einsum('bhncd,bhnsd->bhncs', qc * jnp.exp(bcum - b_ref), kc * jnp.exp(b_ref - bcum))
    tril = jnp.tril(jnp.ones((CHUNK, CHUNK), dtype=bool))
    a = jnp.where(tril, a, 0.0)
    o_intra = jnp.einsum('bhncs,bhnsv->bhncv', a, vc)
    u = jnp.einsum('bhncd,bhncv->bhndv', kc * jnp.exp(b_last - bcum), vc).astype(jnp.float32)
    decay = jnp.exp(b_last[:, :, :, 0, :])

    def step(s, inp):
        dec, uu = inp
        return dec[..., None] * s + uu, s

    s_final, s_starts = lax.scan(step, s0.astype(jnp.float32),
                                 (jnp.moveaxis(decay, 2, 0), jnp.moveaxis(u, 2, 0)))
    s_starts = jnp.moveaxis(s_starts, 0, 2)
    o_inter = jnp.einsum('bhncd,bhndv->bhncv', qc * jnp.exp(bcum), s_starts)
    o = (o_inter + o_intra).reshape(bn, h, l, dv)
    return o.astype(v.dtype), s_final.astype(v.dtype)


def gla_bidir(q, k, v, g_f, g_b, s0_f, s0_b):
    o_f, s_f = gla_chunked(q, k, v, g_f, s0_f)
    flip = lambda t: t[:, :, ::-1]
    o_b, s_b = gla_chunked(flip(q), flip(k), flip(v), flip(g_b), s0_b)
    return o_f + flip(o_b), s_f, s_b


def block(x, cvec, s0_f, s0_b, rows, width,
          w_ada, b_ada, norm1_g, w_in, w_gk_f, b_gk_f, w_gk_b, b_gk_b, gla_norm_g,
          conv_mix_w, w_out, norm2_g, ffn_w_up, ffn_w_gate, ffn_conv_w, ffn_conv_b, ffn_w_down):
    bn, l, _ = x.shape
    mod = (jax.nn.silu(cvec) @ w_ada + b_ada).reshape(cvec.shape[0], 1, N_MOD, D_MODEL)
    sh1, sc1, ga1, sh2, sc2, ga2 = [mod[:, :, i] for i in range(N_MOD)]
    xn = rmsnorm(x, norm1_g) * (1.0 + sc1) + sh1
    q, k, v, g_out, code_f, code_b, c_b, c_c, c_x, gate_a, gate_b = split_cols(xn @ w_in)
    g_f = jax.nn.log_sigmoid((code_f @ w_gk_f + b_gk_f).astype(jnp.float32)) / GATE_NORMALIZER
    g_b = jax.nn.log_sigmoid((code_b @ w_gk_b + b_gk_b).astype(jnp.float32)) / GATE_NORMALIZER
    o, s_f, s_b = gla_bidir(to_heads(q, HEAD_K) * (HEAD_K ** -0.5), to_heads(k, HEAD_K), to_heads(v, HEAD_V),
                            to_heads(g_f, HEAD_K), to_heads(g_b, HEAD_K), s0_f, s0_b)
    o = rmsnorm(o, gla_norm_g).transpose(0, 2, 1, 3).reshape(bn, l, VAL_DIM) * jax.nn.silu(g_out)
    o_conv = c_b * short_conv1d(c_c * c_x, conv_mix_w)
    mix = (jax.nn.sigmoid(gate_a) * o + jax.nn.sigmoid(gate_b) * o_conv) @ w_out
    x = x + ga1 * mix
    xn2 = rmsnorm(x, norm2_g) * (1.0 + sc2) + sh2
    hup = dwconv3x3(xn2 @ ffn_w_up, ffn_conv_w, ffn_conv_b, rows, width)
    y = (jax.nn.silu(hup) * (xn2 @ ffn_w_gate)) @ ffn_w_down
    x = x + ga2 * y
    return x, s_f, s_b


def setup_inputs(seed: int = 0) -> dict:
    key = jax.random.key(seed)
    ks = jax.random.split(key, 26)
    nrm = lambda i, shape, s: jax.random.normal(ks[i], shape, jnp.float32) * s
    d = D_MODEL
    st_shape = (DEC_BATCH, DEPTH, N_HEADS, HEAD_K, HEAD_V)
    return {
        'x_prompt': nrm(0, (BATCH, SEQ, d), 1.0),
        'x_sample': nrm(1, (DEC_BATCH, DEC_SEQ, d), 1.0),
        'c': nrm(2, (DEC_BATCH, d), 1.0),
        'state_gla_fwd': nrm(3, st_shape, 1.0),
        'state_gla_bwd': nrm(4, st_shape, 1.0),
        'c_ctx': nrm(5, (d,), 1.0),
        'w_ada': nrm(6, (DEPTH, d, N_MOD * d), 0.5 * d ** -0.5),
        'b_ada': nrm(7, (DEPTH, N_MOD * d), 0.02),
        'norm1_g': 1.0 + nrm(8, (DEPTH, d), 0.02),
        'w_in': nrm(9, (DEPTH, d, IN_DIM), d ** -0.5),
        'w_gk_f': nrm(10, (DEPTH, GATE_RANK, KEY_DIM), GATE_RANK ** -0.5),
        'b_gk_f': nrm(11, (DEPTH, KEY_DIM), 0.1),
        'w_gk_b': nrm(12, (DEPTH, GATE_RANK, KEY_DIM), GATE_RANK ** -0.5),
        'b_gk_b': nrm(13, (DEPTH, KEY_DIM), 0.1),
        'gla_norm_g': 1.0 + nrm(14, (DEPTH, HEAD_V), 0.02),
        'conv_mix_w': nrm(15, (DEPTH, 3, CONV_DIM), 3 ** -0.5),
        'w_out': nrm(16, (DEPTH, VAL_DIM, d), VAL_DIM ** -0.5),
        'norm2_g': 1.0 + nrm(17, (DEPTH, d), 0.02),
        'ffn_w_up': nrm(18, (DEPTH, d, D_FF), d ** -0.5),
        'ffn_w_gate': nrm(19, (DEPTH, d, D_FF), d ** -0.5),
        'ffn_conv_w': nrm(20, (DEPTH, 3, 3, D_FF), 1.0 / 3.0),
        'ffn_conv_b': nrm(21, (DEPTH, D_FF), 0.02),
        'ffn_w_down': nrm(22, (DEPTH, D_FF, d), D_FF ** -0.5),
        'normf_g': 1.0 + nrm(23, (d,), 0.02),
    }


def reference(x_prompt, x_sample, c, state_gla_fwd, state_gla_bwd, c_ctx, w_ada, b_ada, norm1_g, w_in,
              w_gk_f, b_gk_f, w_gk_b, b_gk_b, gla_norm_g, conv_mix_w, w_out, norm2_g,
              ffn_w_up, ffn_w_gate, ffn_conv_w, ffn_conv_b, ffn_w_down, normf_g):
    bp, lp, _ = x_prompt.shape
    ls = x_sample.shape[1]
    rows = ls // GRID_W
    zero_state = jnp.zeros((bp, N_HEADS, HEAD_K, HEAD_V), x_prompt.dtype)
    xp, xs = x_prompt, x_sample
    new_f, new_b = [], []
    for l in range(DEPTH):
        p = (w_ada[l], b_ada[l], norm1_g[l], w_in[l], w_gk_f[l], b_gk_f[l], w_gk_b[l], b_gk_b[l],
             gla_norm_g[l], conv_mix_w[l], w_out[l], norm2_g[l], ffn_w_up[l], ffn_w_gate[l],
             ffn_conv_w[l], ffn_conv_b[l], ffn_w_down[l])
        xp, s_f, s_b = block(xp, c_ctx[None, :], zero_state, zero_state, 1, lp, *p)
        new_f.append(s_f)
        new_b.append(s_b)
        xs, _, _ = block(xs, c, state_gla_fwd[:, l], state_gla_bwd[:, l], rows, GRID_W, *p)
    y_prompt = rmsnorm(xp, normf_g)
    y_sample = rmsnorm(xs, normf_g)
    return (y_prompt, y_sample, jnp.stack(new_f, axis=1), jnp.stack(new_b, axis=1))
```

```cpp
#include <hip/hip_runtime.h>
#include <cstdio>
#include <cstdint>

#ifndef MK_N_LAUNCHES
#define MK_N_LAUNCHES 1
#endif
constexpr int NWAVES = 8;
constexpr int NTHR = NWAVES * 64;
constexpr int PER_PHASE = 11;
constexpr int N_LAUNCHES = MK_N_LAUNCHES;

constexpr int D = 1024, M_P = 8192, L_P = 256, M_S = 4096, L_S = 1024, M = M_P + M_S;
constexpr int NH = 4, HK = 128, HV = 256, KD = 512, VD = 1024, GR = 16, FF = 2816, FF2 = 2 * FF, IN_DIM = 8224, NMOD = 6;
constexpr int NIN = 8192;
constexpr float EPS = 1e-6f;
constexpr float QSCALE = 0.08838834764831845f;
constexpr int C_Q = 0, C_K = 512, C_V = 1024, C_GO = 2048, C_CF = 3072, C_CB_ = 3088, C_CBR = 3104, C_CC = 4128, C_CX = 5152, C_GA = 6176, C_GB = 7200;

constexpr size_t MiB = 1u << 20;
constexpr size_t WS_CTL = 0, CTL_ZERO_BYTES = 1 * MiB;
constexpr size_t WS_MOD = 1 * MiB;
constexpr size_t WS_XCH = 1 * MiB + 256 * 1024;
constexpr size_t WS_WIN = 2 * MiB;
constexpr size_t WS_WC = 18 * MiB;
constexpr size_t WS_CODES = 18 * MiB + 512 * 1024;
constexpr size_t WS_WOUT = 20 * MiB;
constexpr size_t WS_WUG = 22 * MiB;
constexpr size_t WS_WDN = 33 * MiB;
constexpr size_t WS_BUFA = 40 * MiB;
constexpr size_t WS_BUFB = 64 * MiB;
constexpr size_t WS_QKV = 88 * MiB;
constexpr size_t WS_PP = 136 * MiB;
constexpr size_t WS_A1 = 160 * MiB;
constexpr size_t WS_B1 = 184 * MiB;
constexpr size_t WS_OF = 208 * MiB;
constexpr size_t WS_OB = 232 * MiB;
constexpr size_t WS_ACT = 40 * MiB;
constexpr size_t WS_UG = 106 * MiB;
constexpr size_t WS_END = 256 * MiB;
static_assert(WS_CODES + (size_t)M * 32 * 4 <= WS_WOUT && WS_WDN + (size_t)D * FF * 2 <= WS_BUFA && WS_ACT + (size_t)M * FF * 2 <= WS_UG && WS_UG + (size_t)M * FF2 * 2 <= WS_END, "ws map");
constexpr int CW_TMO = 0, CW_CODE = 1, CW_BAR = 4096;

constexpr int LDS_BYTES = 147456;
constexpr int MISC_OFF = 131072 + 320;

#define GAS __attribute__((address_space(1)))
#define LAS __attribute__((address_space(3)))
typedef unsigned short bf16;
typedef unsigned v4u __attribute__((ext_vector_type(4)));
typedef unsigned v2u __attribute__((ext_vector_type(2)));
typedef float f32x4 __attribute__((ext_vector_type(4)));
typedef GAS unsigned gu32;
#define RLX_AGENT __ATOMIC_RELAXED, __HIP_MEMORY_SCOPE_AGENT
__device__ __forceinline__ unsigned f2bf(float f) { unsigned u = __builtin_bit_cast(unsigned, f); return (u + 0x7fffu + ((u >> 16) & 1u)) >> 16; }
__device__ __forceinline__ unsigned pk2(float lo, float hi) { return f2bf(lo) | (f2bf(hi) << 16); }
__device__ __forceinline__ float bflo(unsigned x) { return __builtin_bit_cast(float, x << 16); }
__device__ __forceinline__ float bfhi(unsigned x) { return __builtin_bit_cast(float, x & 0xffff0000u); }
__device__ __forceinline__ float bf2f(bf16 x) { return __builtin_bit_cast(float, (unsigned)x << 16); }
__device__ __forceinline__ float sigm(float x) { return __builtin_amdgcn_rcpf(1.f + __builtin_amdgcn_exp2f(-1.4426950408889634f * x)); }
__device__ __forceinline__ float logsig(float z) { return fminf(z, 0.f) - log1pf(expf(-fabsf(z))); }
__device__ __forceinline__ float wave_sum(float v) {
#pragma unroll
    for (int o = 1; o < 64; o <<= 1) v += __shfl_xor(v, o);
    return v;
}

#define XB_TMO      128
#define XB_XCNT(j)  (256  + 64 * (j))
#define XB_XSUB(j)  (1280 + 64 * (j))
#define XB_XGEN(j)  (2304 + 64 * (j))
#define XB_TOP      3328
#define XB_TOPGEN   3392
#define XCD_BAR_WORDS 3456
#define XB_SPIN_CAP (1u << 20)
__device__ __forceinline__ unsigned xb_ld(unsigned* p)              { return __hip_atomic_load(p, __ATOMIC_RELAXED, __HIP_MEMORY_SCOPE_AGENT); }
__device__ __forceinline__ unsigned xb_add(unsigned* p, unsigned v) { return __hip_atomic_fetch_add(p, v, __ATOMIC_RELAXED, __HIP_MEMORY_SCOPE_AGENT); }
__device__ __forceinline__ unsigned xb_xcc_id() { return (unsigned)__builtin_amdgcn_s_getreg((3 << 11) | 20) & 0xFu; }
#define XB_SPIN(cond, bar) do { unsigned _sp = 0; while (cond) { __builtin_amdgcn_s_sleep(1); \
    if ((++_sp & 255u) == 0u) { if (xb_ld(&(bar)[XB_TMO])) break; if (_sp > XB_SPIN_CAP) { atomicAdd(&(bar)[XB_TMO], 1u); break; } } } } while (0)
struct XcdBarrier { unsigned* bar; unsigned x; volatile LAS unsigned* st; };
__device__ __forceinline__ XcdBarrier xcd_barrier_post(unsigned* bar, volatile LAS unsigned* st) {
    XcdBarrier b; b.bar = bar; b.x = xb_xcc_id(); b.st = st;
    if (threadIdx.x == 0) (void)xb_add(&bar[XB_XCNT(b.x)], 1u);
    return b;
}
__device__ __forceinline__ void xcd_barrier_complete(unsigned* bar, unsigned x, unsigned& nloc, unsigned& nx) {
    const unsigned G = gridDim.x * gridDim.y * gridDim.z;
    unsigned sum, cnt, mine, sp = 0u;
    for (;;) {
        sum = 0u; cnt = 0u; mine = 0u;
#pragma unroll
        for (unsigned j = 0; j < 16; ++j) { const unsigned c = xb_ld(&bar[XB_XCNT(j)]); sum += c; cnt += (c > 0u) ? 1u : 0u; mine = (j == x) ? c : mine; }
        if (sum == G) break;
        __builtin_amdgcn_s_sleep(1);
        if ((++sp & 255u) == 0u) { if (xb_ld(&bar[XB_TMO])) break; if (sp > XB_SPIN_CAP) { atomicAdd(&bar[XB_TMO], 1u); break; } }
    }
    nloc = mine > 0u ? mine : 1u; nx = cnt > 0u ? cnt : 1u;
}
__device__ __forceinline__ void xcd_barrier(const XcdBarrier& b) {
    asm volatile("s_waitcnt vmcnt(0)" ::: "memory");
    __syncthreads();
    if (threadIdx.x == 0) {
        unsigned* bar = b.bar;
        __builtin_amdgcn_s_waitcnt(0);
        unsigned nloc = b.st[0], nx = b.st[1];
        if (nloc == 0u) { xcd_barrier_complete(bar, b.x, nloc, nx); b.st[0] = nloc; b.st[1] = nx; }
        const unsigned old = xb_add(&bar[XB_XSUB(b.x)], 1u);
        const unsigned gen = old / nloc;
        if (old + 1u == (gen + 1u) * nloc) {
            __builtin_amdgcn_fence(__ATOMIC_RELEASE, "agent");
            asm volatile("s_waitcnt vmcnt(0)" ::: "memory");
            const unsigned og = xb_add(&bar[XB_TOP], 1u);
            const unsigned tg = og / nx;
            if (og + 1u == (tg + 1u) * nx) xb_add(&bar[XB_TOPGEN], 1u);
            else XB_SPIN(xb_ld(&bar[XB_TOPGEN]) == tg, bar);
            __builtin_amdgcn_fence(__ATOMIC_ACQUIRE, "agent");
            xb_add(&bar[XB_XGEN(b.x)], 1u);
            asm volatile("s_waitcnt vmcnt(0)" ::: "memory");
        } else {
            XB_SPIN(xb_ld(&bar[XB_XGEN(b.x)]) == gen, bar);
            __builtin_amdgcn_fence(__ATOMIC_ACQUIRE, "agent");
            asm volatile("s_waitcnt vmcnt(0)" ::: "memory");
        }
    }
    __syncthreads();
}

struct Frame {
    LAS unsigned char* lds;
    volatile LAS unsigned* MISC;
    gu32* ctl;
    int tid, lane, wave, G, vcu;
    int gtid, NT, gw, NGW;
    const float *xp, *xs, *c, *st_f, *st_b, *c_ctx, *w_ada, *b_ada, *g1, *w_in, *wgk_f, *bgk_f, *wgk_b, *bgk_b, *gla_g, *cmw, *w_out, *g2, *w_up, *w_gate, *fcw, *fcb, *w_down, *gf;
    float* out;
    float* MOD; float* CODES;
    bf16 *WIN, *WC, *WOUT, *WUG, *WDN, *BUFA, *BUFB, *QKV, *PP, *A1, *B1, *OF, *OB, *ACT, *UG;
};
__device__ __forceinline__ const float* xrow(const Frame& F, int m) { return m < M_P ? F.xp + (size_t)m * D : F.xs + (size_t)(m - M_P) * D; }
__device__ __forceinline__ int modrow(int m) { return m < M_P ? 0 : 1 + ((m - M_P) >> 10); }

__device__ __forceinline__ float dot_bf16(const bf16* a, const bf16* b, int K) {
    float s = 0.f;
    for (int k = 0; k < K; k += 8) {
        const v4u av = *(const v4u*)(a + k), bv = *(const v4u*)(b + k);
#pragma unroll
        for (int j = 0; j < 4; ++j) { s += bflo(av[j]) * bflo(bv[j]); s += bfhi(av[j]) * bfhi(bv[j]); }
    }
    return s;
}
__device__ __forceinline__ void dot2_bf16(const bf16* a, const bf16* b0, const bf16* b1, int K, float& r0, float& r1) {
    float s0 = 0.f, s1 = 0.f;
    for (int k = 0; k < K; k += 8) {
        const v4u av = *(const v4u*)(a + k), bv = *(const v4u*)(b0 + k), cv = *(const v4u*)(b1 + k);
#pragma unroll
        for (int j = 0; j < 4; ++j) { const float al = bflo(av[j]), ah = bfhi(av[j]);
            s0 += al * bflo(bv[j]); s0 += ah * bfhi(bv[j]); s1 += al * bflo(cv[j]); s1 += ah * bfhi(cv[j]); }
    }
    r0 = s0; r1 = s1;
}
__device__ __forceinline__ void conv_wt(const Frame& F, const float* src, int ldN, int srccol0, bf16* dst, int K, int nrows, int dstrow0) {
    const int total = nrows * (K / 8);
    for (int i = F.gtid; i < total; i += F.NT) {
        const int n = i % nrows, k8 = i / nrows; const float* s = src + (size_t)(k8 * 8) * ldN + srccol0 + n;
        v4u o; o.x = pk2(s[0], s[(size_t)ldN]); o.y = pk2(s[(size_t)2 * ldN], s[(size_t)3 * ldN]); o.z = pk2(s[(size_t)4 * ldN], s[(size_t)5 * ldN]); o.w = pk2(s[(size_t)6 * ldN], s[(size_t)7 * ldN]);
        *(v4u*)(dst + (size_t)(dstrow0 + n) * K + k8 * 8) = o;
    }
}
__device__ __forceinline__ int win_segbase(int s) {
    if (s < 16) return 128 * s;
    const int pn = s >> 1, half = s & 1, t = (pn - 8) >> 3, pp = (pn - 8) & 7;
    const int first = t == 0 ? C_CC : (t == 1 ? C_GA : C_GB), second = t == 0 ? C_CX : (t == 1 ? C_GO : C_CBR);
    return (half == 0 ? first : second) + 128 * pp;
}

__device__ __forceinline__ void p0_prologue(Frame& F) {
    if (blockIdx.x < 96) {
        LAS float* sl = (LAS float*)F.lds;
        LAS float* red = sl + 5 * 1024;
        for (int i = F.tid; i < 5 * 1024; i += NTHR) { const int r = i >> 10, k = i & 1023; const float v = (r == 0) ? F.c_ctx[k] : F.c[(r - 1) * 1024 + k]; sl[i] = v * sigm(v); }
        __syncthreads();
        const int cc = F.tid & 63, kc = F.tid >> 6, col = blockIdx.x * 64 + cc;
        float a0 = 0.f, a1 = 0.f, a2 = 0.f, a3 = 0.f, a4 = 0.f;
#pragma unroll 8
        for (int k = kc * 128; k < kc * 128 + 128; ++k) { const float w = F.w_ada[(size_t)k * (NMOD * D) + col];
            a0 += sl[k] * w; a1 += sl[1024 + k] * w; a2 += sl[2048 + k] * w; a3 += sl[3072 + k] * w; a4 += sl[4096 + k] * w; }
        red[(kc * 5 + 0) * 64 + cc] = a0; red[(kc * 5 + 1) * 64 + cc] = a1; red[(kc * 5 + 2) * 64 + cc] = a2; red[(kc * 5 + 3) * 64 + cc] = a3; red[(kc * 5 + 4) * 64 + cc] = a4;
        __syncthreads();
        if (F.tid < 320) { const int r = F.tid >> 6; float s = F.b_ada[blockIdx.x * 64 + cc];
#pragma unroll
            for (int q = 0; q < 8; ++q) s += red[(q * 5 + r) * 64 + cc];
            F.MOD[r * (NMOD * D) + blockIdx.x * 64 + cc] = s; }
        __syncthreads();
    }
    for (int s = 0; s < 64; ++s) conv_wt(F, F.w_in, IN_DIM, win_segbase(s), F.WIN, D, 128, 128 * s);
    conv_wt(F, F.w_in, IN_DIM, C_CF, F.WC, D, 32, 0);
    conv_wt(F, F.w_out, D, 0, F.WOUT, D, D, 0);
    conv_wt(F, F.w_up, FF, 0, F.WUG, D, FF, 0);
    conv_wt(F, F.w_gate, FF, 0, F.WUG, D, FF, FF);
    conv_wt(F, F.w_down, D, 0, F.WDN, FF, D, 0);
}

__device__ __forceinline__ void norm_mod_row(const float* xr_, const float* g, const float* sc, const float* sh, bf16* orow, int lane) {
    const f32x4* xr = (const f32x4*)xr_ + lane;
    f32x4 v[4]; float s = 0.f;
#pragma unroll
    for (int j = 0; j < 4; ++j) { v[j] = xr[64 * j]; s += (v[j].x * v[j].x + v[j].y * v[j].y) + (v[j].z * v[j].z + v[j].w * v[j].w); }
    const float rstd = 1.0f / sqrtf(wave_sum(s) * (1.f / D) + EPS);
#pragma unroll
    for (int j = 0; j < 4; ++j) {
        const int c0 = 4 * lane + 256 * j;
        const f32x4 gg = *(const f32x4*)(g + c0), s1 = *(const f32x4*)(sc + c0), h1 = *(const f32x4*)(sh + c0);
        const f32x4 y = (v[j] * rstd) * gg * (s1 + 1.0f) + h1;
        v2u o; o.x = pk2(y.x, y.y); o.y = pk2(y.z, y.w);
        *(v2u*)(orow + c0) = o;
    }
}
__device__ __forceinline__ void p1_xn(Frame& F) {
    for (int m = F.gw; m < M; m += F.NGW) { const float* md = F.MOD + modrow(m) * (NMOD * D);
        norm_mod_row(xrow(F, m), F.g1, md + 1 * D, md + 0 * D, F.BUFA + (size_t)m * D, F.lane); }
}

__device__ __forceinline__ void epi_inproj(const Frame& F, int pn, int m, int c, float a0, float a1) {
    if (pn < 8) { const int col = 256 * pn + c, col2 = col + 128;
        F.QKV[(size_t)m * 2048 + col] = (bf16)f2bf(a0 * (col < 512 ? QSCALE : 1.f)); F.QKV[(size_t)m * 2048 + col2] = (bf16)f2bf(a1 * (col2 < 512 ? QSCALE : 1.f)); }
    else if (pn < 16) F.PP[(size_t)m * 1024 + 128 * (pn - 8) + c] = (bf16)f2bf(a0 * a1);
    else if (pn < 24) F.A1[(size_t)m * 1024 + 128 * (pn - 16) + c] = (bf16)f2bf(sigm(a0) * a1 * sigm(a1));
    else F.B1[(size_t)m * 1024 + 128 * (pn - 24) + c] = (bf16)f2bf(sigm(a0) * a1);
}
__device__ __forceinline__ void p2_inproj_naive(Frame& F) {
    const long total = (long)M * 4096;
    for (long i = F.gtid; i < total; i += F.NT) {
        const int m = (int)(i >> 12), r = (int)(i & 4095), pn = r >> 7, c = r & 127;
        float a0, a1; dot2_bf16(F.BUFA + (size_t)m * D, F.WIN + (size_t)(256 * pn + c) * D, F.WIN + (size_t)(256 * pn + 128 + c) * D, D, a0, a1);
        epi_inproj(F, pn, m, c, a0, a1);
    }
    for (int i = F.gtid; i < M * 32; i += F.NT) { const int m = i >> 5, j = i & 31; F.CODES[i] = dot_bf16(F.BUFA + (size_t)m * D, F.WC + (size_t)j * D, D); }
}

__device__ __forceinline__ void p3_gla_naive(Frame& F) {
    LAS float* qs = (LAS float*)F.lds; LAS float* ks = qs + 64 * 128; LAS float* eg = ks + 64 * 128;
    for (int u = blockIdx.x; u < 288; u += F.G) {
        int b, h, dir, L, row0; const float* s0 = nullptr;
        if (u < 32) { b = u >> 3; h = (u >> 1) & 3; dir = u & 1; L = L_S; row0 = M_P + b * L_S; s0 = (dir ? F.st_b : F.st_f) + (size_t)(b * NH + h) * HK * HV; }
        else { const int up = u - 32; b = up >> 3; h = (up >> 1) & 3; dir = up & 1; L = L_P; row0 = b * L_P; }
        const float* wgk = dir ? F.wgk_b : F.wgk_f; const float* bgk = dir ? F.bgk_b : F.bgk_f;
        bf16* O = dir ? F.OB : F.OF;
        const int v = F.tid & 255;
        float S[HK];
#pragma unroll
        for (int d = 0; d < HK; ++d) S[d] = s0 ? s0[d * HV + v] : 0.f;
        for (int n = 0; n < L / 64; ++n) {
            __syncthreads();
            for (int i = F.tid; i < 64 * 128; i += NTHR) {
                const int j = i >> 7, d = i & 127, t = n * 64 + j, m = row0 + (dir ? L - 1 - t : t);
                qs[i] = bf2f(F.QKV[(size_t)m * 2048 + h * HK + d]); ks[i] = bf2f(F.QKV[(size_t)m * 2048 + KD + h * HK + d]);
                float z = bgk[h * HK + d];
#pragma unroll
                for (int r = 0; r < GR; ++r) z += F.CODES[m * 32 + dir * 16 + r] * wgk[r * KD + h * HK + d];
                eg[i] = expf(logsig(z) * (1.0f / 16.0f));
            }
            __syncthreads();
            if (F.tid < 256) {
                for (int j = 0; j < 64; ++j) {
                    const int t = n * 64 + j, m = row0 + (dir ? L - 1 - t : t);
                    const float vv = bf2f(F.QKV[(size_t)m * 2048 + 2 * KD + h * HV + v]); float o = 0.f;
#pragma unroll
                    for (int d = 0; d < HK; ++d) { S[d] = S[d] * eg[j * 128 + d] + ks[j * 128 + d] * vv; o += qs[j * 128 + d] * S[d]; }
                    O[(size_t)m * VD + h * HV + v] = (bf16)f2bf(o);
                }
            }
        }
        if (u >= 32 && F.tid < 256) { float* so = F.out + (size_t)M * D + (size_t)dir * (32 * NH * HK * HV) + (size_t)(b * NH + h) * HK * HV;
#pragma unroll
            for (int d = 0; d < HK; ++d) so[d * HV + v] = S[d]; }
    }
    __syncthreads();
}

__device__ __forceinline__ f32x4 ld4bf(const bf16* p) { const v2u w = *(const v2u*)p; return (f32x4){bflo(w.x), bfhi(w.x), bflo(w.y), bfhi(w.y)}; }
__device__ __forceinline__ void p3b_mixprep(Frame& F) {
    for (int it = F.gw; it < M * NH; it += F.NGW) {
        const int m = it >> 2, h = it & 3, c0 = h * HV + 4 * F.lane;
        const int L = m < M_P ? L_P : L_S, t = m < M_P ? (m & (L_P - 1)) : ((m - M_P) & (L_S - 1));
        const size_t off = (size_t)m * VD + c0;
        const f32x4 o = ld4bf(F.OF + off) + ld4bf(F.OB + off);
        const float ss = wave_sum((o.x * o.x + o.y * o.y) + (o.z * o.z + o.w * o.w));
        const float rstd = 1.0f / sqrtf(ss * (1.f / HV) + EPS);
        const f32x4 on = (o * rstd) * *(const f32x4*)(F.gla_g + 4 * F.lane);
        const f32x4 z4 = (f32x4){0.f, 0.f, 0.f, 0.f};
        const f32x4 p0 = ld4bf(F.PP + off), pm = t > 0 ? ld4bf(F.PP + off - VD) : z4, pp = t < L - 1 ? ld4bf(F.PP + off + VD) : z4;
        const f32x4 cv = *(const f32x4*)(F.cmw + c0) * pm + *(const f32x4*)(F.cmw + D + c0) * p0 + *(const f32x4*)(F.cmw + 2 * D + c0) * pp;
        const f32x4 mx = ld4bf(F.A1 + off) * on + ld4bf(F.B1 + off) * cv;
        v2u w; w.x = pk2(mx.x, mx.y); w.y = pk2(mx.z, mx.w);
        *(v2u*)(F.BUFB + off) = w;
    }
}

__device__ __forceinline__ void p4a_naive(Frame& F) {
    for (int i = F.gtid; i < M * D; i += F.NT) { const int m = i >> 10, n = i & 1023;
        const float acc = dot_bf16(F.BUFB + (size_t)m * D, F.WOUT + (size_t)n * D, D);
        F.out[i] = xrow(F, m)[n] + F.MOD[modrow(m) * (NMOD * D) + 2 * D + n] * acc; }
}
__device__ __forceinline__ void p4b_norm2(Frame& F) {
    for (int m = F.gw; m < M; m += F.NGW) { const float* md = F.MOD + modrow(m) * (NMOD * D);
        norm_mod_row(F.out + (size_t)m * D, F.g2, md + 4 * D, md + 3 * D, F.BUFA + (size_t)m * D, F.lane); }
}
__device__ __forceinline__ void p5_naive(Frame& F) {
    const long total = (long)M * FF2;
    for (long i = F.gtid; i < total; i += F.NT) { const int m = (int)(i / FF2), n = (int)(i % FF2);
        F.UG[i] = (bf16)f2bf(dot_bf16(F.BUFA + (size_t)m * D, F.WUG + (size_t)n * D, D)); }
}
__device__ __forceinline__ void p5b_act(Frame& F) {
    const int total = M * (FF / 8);
    for (int i = F.gtid; i < total; i += F.NT) {
        const int m = i / (FF / 8), f0 = 8 * (i % (FF / 8));
        float acc[8];
        { const f32x4 b0 = *(const f32x4*)(F.fcb + f0), b1 = *(const f32x4*)(F.fcb + f0 + 4); acc[0] = b0.x; acc[1] = b0.y; acc[2] = b0.z; acc[3] = b0.w; acc[4] = b1.x; acc[5] = b1.y; acc[6] = b1.z; acc[7] = b1.w; }
        int y, x, H, W;
        if (m < M_P) { y = 0; x = m & (L_P - 1); H = 1; W = L_P; } else { const int p = (m - M_P) & (L_S - 1); y = p >> 6; x = p & 63; H = 16; W = 64; }
#pragma unroll
        for (int ky = 0; ky < 3; ++ky)
#pragma unroll
            for (int kx = 0; kx < 3; ++kx) {
                const int yy = y + ky - 1, xx = x + kx - 1;
                if (yy >= 0 && yy < H && xx >= 0 && xx < W) {
                    const int m2 = m + (ky - 1) * W + (kx - 1);
                    const v4u uv = *(const v4u*)(F.UG + (size_t)m2 * FF2 + f0);
                    const float* w = F.fcw + (size_t)(ky * 3 + kx) * FF + f0; const f32x4 w0 = *(const f32x4*)w, w1 = *(const f32x4*)(w + 4);
                    acc[0] += w0.x * bflo(uv.x); acc[1] += w0.y * bfhi(uv.x); acc[2] += w0.z * bflo(uv.y); acc[3] += w0.w * bfhi(uv.y);
                    acc[4] += w1.x * bflo(uv.z); acc[5] += w1.y * bfhi(uv.z); acc[6] += w1.z * bflo(uv.w); acc[7] += w1.w * bfhi(uv.w);
                }
            }
        const v4u gv = *(const v4u*)(F.UG + (size_t)m * FF2 + FF + f0);
        float r[8];
        r[0] = acc[0] * sigm(acc[0]) * bflo(gv.x); r[1] = acc[1] * sigm(acc[1]) * bfhi(gv.x); r[2] = acc[2] * sigm(acc[2]) * bflo(gv.y); r[3] = acc[3] * sigm(acc[3]) * bfhi(gv.y);
        r[4] = acc[4] * sigm(acc[4]) * bflo(gv.z); r[5] = acc[5] * sigm(acc[5]) * bfhi(gv.z); r[6] = acc[6] * sigm(acc[6]) * bflo(gv.w); r[7] = acc[7] * sigm(acc[7]) * bfhi(gv.w);
        v4u o; o.x = pk2(r[0], r[1]); o.y = pk2(r[2], r[3]); o.z = pk2(r[4], r[5]); o.w = pk2(r[6], r[7]);
        *(v4u*)(F.ACT + (size_t)m * FF + f0) = o;
    }
}
__device__ __forceinline__ void p6a_naive(Frame& F) {
    for (int i = F.gtid; i < M * D; i += F.NT) { const int m = i >> 10, n = i & 1023;
        const float acc = dot_bf16(F.ACT + (size_t)m * FF, F.WDN + (size_t)n * FF, FF);
        F.out[i] = F.out[i] + F.MOD[modrow(m) * (NMOD * D) + 5 * D + n] * acc; }
}
__device__ __forceinline__ void p6b_normf(Frame& F) {
    for (int m = F.gw; m < M; m += F.NGW) {
        f32x4* xr = (f32x4*)(F.out + (size_t)m * D) + F.lane;
        f32x4 v[4]; float s = 0.f;
#pragma unroll
        for (int j = 0; j < 4; ++j) { v[j] = xr[64 * j]; s += (v[j].x * v[j].x + v[j].y * v[j].y) + (v[j].z * v[j].z + v[j].w * v[j].w); }
        const float rstd = 1.0f / sqrtf(wave_sum(s) * (1.f / D) + EPS);
#pragma unroll
        for (int j = 0; j < 4; ++j) xr[64 * j] = (v[j] * rstd) * *(const f32x4*)(F.gf + 4 * F.lane + 256 * j);
    }
}

struct Args { const float* in[24]; float* out; unsigned char* ws; int ph_lo, ph_hi; };
__global__ void __launch_bounds__(NTHR, 2) fwd_kernel(Args args) {
    __shared__ __attribute__((aligned(16))) unsigned char lds_raw[LDS_BYTES];
    Frame F;
    F.lds = (LAS unsigned char*)lds_raw;
    F.MISC = (volatile LAS unsigned*)(F.lds + MISC_OFF);
    F.tid = threadIdx.x; F.lane = F.tid & 63; F.wave = __builtin_amdgcn_readfirstlane(F.tid >> 6);
    F.G = gridDim.x; { const int bx = blockIdx.x; F.vcu = (F.G % 8 == 0) ? (bx % 8) * (F.G / 8) + bx / 8 : bx; }
    F.gtid = blockIdx.x * NTHR + F.tid; F.NT = F.G * NTHR; F.gw = blockIdx.x * NWAVES + F.wave; F.NGW = F.G * NWAVES;
    unsigned char* ws = args.ws;
    F.ctl = (gu32*)(ws + WS_CTL);
    F.xp = args.in[0]; F.xs = args.in[1]; F.c = args.in[2]; F.st_f = args.in[3]; F.st_b = args.in[4]; F.c_ctx = args.in[5]; F.w_ada = args.in[6]; F.b_ada = args.in[7];
    F.g1 = args.in[8]; F.w_in = args.in[9]; F.wgk_f = args.in[10]; F.bgk_f = args.in[11]; F.wgk_b = args.in[12]; F.bgk_b = args.in[13]; F.gla_g = args.in[14]; F.cmw = args.in[15];
    F.w_out = args.in[16]; F.g2 = args.in[17]; F.w_up = args.in[18]; F.w_gate = args.in[19]; F.fcw = args.in[20]; F.fcb = args.in[21]; F.w_down = args.in[22]; F.gf = args.in[23];
    F.out = args.out;
    F.MOD = (float*)(ws + WS_MOD); F.CODES = (float*)(ws + WS_CODES);
    F.WIN = (bf16*)(ws + WS_WIN); F.WC = (bf16*)(ws + WS_WC); F.WOUT = (bf16*)(ws + WS_WOUT); F.WUG = (bf16*)(ws + WS_WUG); F.WDN = (bf16*)(ws + WS_WDN);
    F.BUFA = (bf16*)(ws + WS_BUFA); F.BUFB = (bf16*)(ws + WS_BUFB); F.QKV = (bf16*)(ws + WS_QKV); F.PP = (bf16*)(ws + WS_PP); F.A1 = (bf16*)(ws + WS_A1); F.B1 = (bf16*)(ws + WS_B1);
    F.OF = (bf16*)(ws + WS_OF); F.OB = (bf16*)(ws + WS_OB); F.ACT = (bf16*)(ws + WS_ACT); F.UG = (bf16*)(ws + WS_UG);
    for (int u = F.tid; u < (LDS_BYTES - 131072) / 4; u += NTHR) ((LAS unsigned*)(F.lds + 131072))[u] = 0u;
    __syncthreads();
    XcdBarrier bar; bar.bar = (unsigned*)(F.ctl + CW_BAR); bar.x = 0; bar.st = nullptr;
    if (N_LAUNCHES != PER_PHASE) bar = xcd_barrier_post((unsigned*)(F.ctl + CW_BAR), F.MISC + 8);
#define GRID_BAR() do { if (N_LAUNCHES == PER_PHASE) { if (F.tid == 0) __hip_atomic_store(F.ctl + CW_TMO, 0xBADBA0u, RLX_AGENT); } else { xcd_barrier(bar); } } while (0)
    const int lo = args.ph_lo, hi = args.ph_hi;
#define IN(k) (lo <= (k) && (k) < hi)
#define BOTH(k) (IN(k) && IN((k) + 1))
    if (IN(0)) { p0_prologue(F); if (BOTH(0)) GRID_BAR(); }
    if (IN(1)) { p1_xn(F); if (BOTH(1)) GRID_BAR(); }
    if (IN(2)) { p2_inproj_naive(F); if (BOTH(2)) GRID_BAR(); }
    if (IN(3)) { p3_gla_naive(F); if (BOTH(3)) GRID_BAR(); }
    if (IN(4)) { p3b_mixprep(F); if (BOTH(4)) GRID_BAR(); }
    if (IN(5)) { p4a_naive(F); if (BOTH(5)) GRID_BAR(); }
    if (IN(6)) { p4b_norm2(F); if (BOTH(6)) GRID_BAR(); }
    if (IN(7)) { p5_naive(F); if (BOTH(7)) GRID_BAR(); }
    if (IN(8)) { p5b_act(F); if (BOTH(8)) GRID_BAR(); }
    if (IN(9)) { p6a_naive(F); if (BOTH(9)) GRID_BAR(); }
    if (IN(10)) { p6b_normf(F); }
#undef IN
#undef BOTH
}

extern "C" void kernel_launch(void* const* d_in, const int* in_sizes, int n_in, void* d_out, int out_size, void* d_ws, size_t ws_size, hipStream_t stream) {
    static int grid = 0;
    if (grid == 0) {
        if (n_in != 24 || in_sizes[0] != M_P * D || in_sizes[1] != M_S * D || out_size != M * D + 2 * 32 * NH * HK * HV || ws_size < WS_END) {
            fprintf(stderr, "kernel_launch: unexpected shapes: n_in %d in0 %d in1 %d out %d ws %zu; nothing launched\n", n_in, n_in > 0 ? in_sizes[0] : -1, n_in > 1 ? in_sizes[1] : -1, out_size, ws_size); grid = -1; return; }
        int dev = 0, cus = 0, per_cu = 0;
        if (hipGetDevice(&dev) != hipSuccess || hipDeviceGetAttribute(&cus, hipDeviceAttributeMultiprocessorCount, dev) != hipSuccess) { fprintf(stderr, "kernel_launch: device query failed\n"); grid = -1; return; }
        if (hipOccupancyMaxActiveBlocksPerMultiprocessor(&per_cu, (const void*)fwd_kernel, NTHR, 0) != hipSuccess || per_cu < 1) { fprintf(stderr, "kernel_launch: occupancy query says %d blocks per CU\n", per_cu); (void)hipGetLastError(); grid = -1; return; }
        grid = cus;
    }
    if (grid < 0) return;
    if (hipMemsetAsync((char*)d_ws + WS_CTL, 0, CTL_ZERO_BYTES, stream) != hipSuccess) { fprintf(stderr, "kernel_launch: memset failed\n"); return; }
    Args a{};
    for (int i = 0; i < 24; ++i) a.in[i] = (const float*)d_in[i];
    a.out = (float*)d_out; a.ws = (unsigned char*)d_ws;
    if (N_LAUNCHES == 1) { a.ph_lo = 0; a.ph_hi = PER_PHASE; hipLaunchKernelGGL(fwd_kernel, dim3(grid), dim3(NTHR), 0, stream, a); }
    else for (int li = 0; li < PER_PHASE; ++li) { a.ph_lo = li; a.ph_hi = li + 1; hipLaunchKernelGGL(fwd_kernel, dim3(grid), dim3(NTHR), 0, stream, a); }
}
```

```cpp
#include <hip/hip_runtime.h>
#include <cstdio>
#include <cstdint>

#ifndef MK_N_LAUNCHES
#define MK_N_LAUNCHES 1
#endif
#ifndef MFMA_P2
#define MFMA_P2 1
#endif
#ifndef MFMA_P4
#define MFMA_P4 1
#endif
#ifndef MFMA_P5
#define MFMA_P5 1
#endif
#ifndef MFMA_P6
#define MFMA_P6 1
#endif
#ifndef GLA_MFMA
#define GLA_MFMA 1
#endif
#ifndef CODES_MFMA
#define CODES_MFMA 1
#endif
#ifndef P0_FAST
#define P0_FAST 1
#endif
constexpr int NWAVES = 8;
constexpr int NTHR = NWAVES * 64;
constexpr int PER_PHASE = 11;
constexpr int N_LAUNCHES = MK_N_LAUNCHES;

constexpr int D = 1024, M_P = 8192, L_P = 256, M_S = 4096, L_S = 1024, M = M_P + M_S;
constexpr int NH = 4, HK = 128, HV = 256, KD = 512, VD = 1024, GR = 16, FF = 2816, FF2 = 2 * FF, IN_DIM = 8224, NMOD = 6;
constexpr int NIN = 8192;
constexpr float EPS = 1e-6f;
constexpr float QSCALE = 0.08838834764831845f;
constexpr int C_Q = 0, C_K = 512, C_V = 1024, C_GO = 2048, C_CF = 3072, C_CB_ = 3088, C_CBR = 3104, C_CC = 4128, C_CX = 5152, C_GA = 6176, C_GB = 7200;

constexpr size_t MiB = 1u << 20;
constexpr size_t WS_CTL = 0, CTL_ZERO_BYTES = 1 * MiB;
constexpr size_t WS_MOD = 1 * MiB;
constexpr size_t WS_XCH = 1 * MiB + 256 * 1024;
constexpr size_t WS_WIN = 2 * MiB;
constexpr size_t WS_WC = 18 * MiB;
constexpr size_t WS_CODES = 18 * MiB + 512 * 1024;
constexpr size_t WS_WOUT = 20 * MiB;
constexpr size_t WS_WUG = 22 * MiB;
constexpr size_t WS_WDN = 33 * MiB;
constexpr size_t WS_BUFA = 40 * MiB;
constexpr size_t WS_BUFB = 64 * MiB;
constexpr size_t WS_QKV = 88 * MiB;
constexpr size_t WS_PP = 136 * MiB;
constexpr size_t WS_A1 = 160 * MiB;
constexpr size_t WS_B1 = 184 * MiB;
constexpr size_t WS_OF = 208 * MiB;
constexpr size_t WS_OB = 232 * MiB;
constexpr size_t WS_ACT = 40 * MiB;
constexpr size_t WS_UG = 106 * MiB;
constexpr size_t WS_END = 256 * MiB;
static_assert(WS_CODES + (size_t)M * 32 * 4 <= WS_WOUT && WS_WDN + (size_t)D * FF * 2 <= WS_BUFA && WS_ACT + (size_t)M * FF * 2 <= WS_UG && WS_UG + (size_t)M * FF2 * 2 <= WS_END, "ws map");
constexpr int CW_TMO = 0, CW_CODE = 1, CW_BAR = 4096;

constexpr int LDS_BYTES = 147456;
constexpr int MISC_OFF = 131072 + 320;

#define GAS __attribute__((address_space(1)))
#define LAS __attribute__((address_space(3)))
typedef unsigned short bf16;
typedef unsigned v4u __attribute__((ext_vector_type(4)));
typedef unsigned v2u __attribute__((ext_vector_type(2)));
typedef float f32x4 __attribute__((ext_vector_type(4)));
typedef GAS unsigned gu32;
#define RLX_AGENT __ATOMIC_RELAXED, __HIP_MEMORY_SCOPE_AGENT
__device__ __forceinline__ unsigned f2bf(float f) { unsigned u = __builtin_bit_cast(unsigned, f); return (u + 0x7fffu + ((u >> 16) & 1u)) >> 16; }
__device__ __forceinline__ unsigned pk2(float lo, float hi) { return f2bf(lo) | (f2bf(hi) << 16); }
__device__ __forceinline__ float bflo(unsigned x) { return __builtin_bit_cast(float, x << 16); }
__device__ __forceinline__ float bfhi(unsigned x) { return __builtin_bit_cast(float, x & 0xffff0000u); }
__device__ __forceinline__ float bf2f(bf16 x) { return __builtin_bit_cast(float, (unsigned)x << 16); }
__device__ __forceinline__ float sigm(float x) { return __builtin_amdgcn_rcpf(1.f + __builtin_amdgcn_exp2f(-1.4426950408889634f * x)); }
__device__ __forceinline__ float logsig(float z) { return fminf(z, 0.f) - log1pf(expf(-fabsf(z))); }
__device__ __forceinline__ float wave_sum(float v) {
#pragma unroll
    for (int o = 1; o < 64; o <<= 1) v += __shfl_xor(v, o);
    return v;
}

#define XB_TMO      128
#define XB_XCNT(j)  (256  + 64 * (j))
#define XB_XSUB(j)  (1280 + 64 * (j))
#define XB_XGEN(j)  (2304 + 64 * (j))
#define XB_TOP      3328
#define XB_TOPGEN   3392
#define XCD_BAR_WORDS 3456
#define XB_SPIN_CAP (1u << 20)
__device__ __forceinline__ unsigned xb_ld(unsigned* p)              { return __hip_atomic_load(p, __ATOMIC_RELAXED, __HIP_MEMORY_SCOPE_AGENT); }
__device__ __forceinline__ unsigned xb_add(unsigned* p, unsigned v) { return __hip_atomic_fetch_add(p, v, __ATOMIC_RELAXED, __HIP_MEMORY_SCOPE_AGENT); }
__device__ __forceinline__ unsigned xb_xcc_id() { return (unsigned)__builtin_amdgcn_s_getreg((3 << 11) | 20) & 0xFu; }
#define XB_SPIN(cond, bar) do { unsigned _sp = 0; while (cond) { __builtin_amdgcn_s_sleep(1); \
    if ((++_sp & 255u) == 0u) { if (xb_ld(&(bar)[XB_TMO])) break; if (_sp > XB_SPIN_CAP) { atomicAdd(&(bar)[XB_TMO], 1u); break; } } } } while (0)
struct XcdBarrier { unsigned* bar; unsigned x; volatile LAS unsigned* st; };
__device__ __forceinline__ XcdBarrier xcd_barrier_post(unsigned* bar, volatile LAS unsigned* st) {
    XcdBarrier b; b.bar = bar; b.x = xb_xcc_id(); b.st = st;
    if (threadIdx.x == 0) (void)xb_add(&bar[XB_XCNT(b.x)], 1u);
    return b;
}
__device__ __forceinline__ void xcd_barrier_complete(unsigned* bar, unsigned x, unsigned& nloc, unsigned& nx) {
    const unsigned G = gridDim.x * gridDim.y * gridDim.z;
    unsigned sum, cnt, mine, sp = 0u;
    for (;;) {
        sum = 0u; cnt = 0u; mine = 0u;
#pragma unroll
        for (unsigned j = 0; j < 16; ++j) { const unsigned c = xb_ld(&bar[XB_XCNT(j)]); sum += c; cnt += (c > 0u) ? 1u : 0u; mine = (j == x) ? c : mine; }
        if (sum == G) break;
        __builtin_amdgcn_s_sleep(1);
        if ((++sp & 255u) == 0u) { if (xb_ld(&bar[XB_TMO])) break; if (sp > XB_SPIN_CAP) { atomicAdd(&bar[XB_TMO], 1u); break; } }
    }
    nloc = mine > 0u ? mine : 1u; nx = cnt > 0u ? cnt : 1u;
}
__device__ __forceinline__ void xcd_barrier(const XcdBarrier& b) {
    asm volatile("s_waitcnt vmcnt(0)" ::: "memory");
    __syncthreads();
    if (threadIdx.x == 0) {
        unsigned* bar = b.bar;
        __builtin_amdgcn_s_waitcnt(0);
        unsigned nloc = b.st[0], nx = b.st[1];
        if (nloc == 0u) { xcd_barrier_complete(bar, b.x, nloc, nx); b.st[0] = nloc; b.st[1] = nx; }
        const unsigned old = xb_add(&bar[XB_XSUB(b.x)], 1u);
        const unsigned gen = old / nloc;
        if (old + 1u == (gen + 1u) * nloc) {
            __builtin_amdgcn_fence(__ATOMIC_RELEASE, "agent");
            asm volatile("s_waitcnt vmcnt(0)" ::: "memory");
            const unsigned og = xb_add(&bar[XB_TOP], 1u);
            const unsigned tg = og / nx;
            if (og + 1u == (tg + 1u) * nx) xb_add(&bar[XB_TOPGEN], 1u);
            else XB_SPIN(xb_ld(&bar[XB_TOPGEN]) == tg, bar);
            __builtin_amdgcn_fence(__ATOMIC_ACQUIRE, "agent");
            xb_add(&bar[XB_XGEN(b.x)], 1u);
            asm volatile("s_waitcnt vmcnt(0)" ::: "memory");
        } else {
            XB_SPIN(xb_ld(&bar[XB_XGEN(b.x)]) == gen, bar);
            __builtin_amdgcn_fence(__ATOMIC_ACQUIRE, "agent");
            asm volatile("s_waitcnt vmcnt(0)" ::: "memory");
        }
    }
    __syncthreads();
}

struct Frame {
    LAS unsigned char* lds;
    volatile LAS unsigned* MISC;
    gu32* ctl;
    int tid, lane, wave, G, vcu;
    int gtid, NT, gw, NGW;
    const float *xp, *xs, *c, *st_f, *st_b, *c_ctx, *w_ada, *b_ada, *g1, *w_in, *wgk_f, *bgk_f, *wgk_b, *bgk_b, *gla_g, *cmw, *w_out, *g2, *w_up, *w_gate, *fcw, *fcb, *w_down, *gf;
    float* out;
    float* MOD; float* CODES;
    bf16 *WIN, *WC, *WOUT, *WUG, *WDN, *BUFA, *BUFB, *QKV, *PP, *A1, *B1, *OF, *OB, *ACT, *UG;
};
__device__ __forceinline__ const float* xrow(const Frame& F, int m) { return m < M_P ? F.xp + (size_t)m * D : F.xs + (size_t)(m - M_P) * D; }
__device__ __forceinline__ int modrow(int m) { return m < M_P ? 0 : 1 + ((m - M_P) >> 10); }

__device__ __forceinline__ float dot_bf16(const bf16* a, const bf16* b, int K) {
    float s = 0.f;
    for (int k = 0; k < K; k += 8) {
        const v4u av = *(const v4u*)(a + k), bv = *(const v4u*)(b + k);
#pragma unroll
        for (int j = 0; j < 4; ++j) { s += bflo(av[j]) * bflo(bv[j]); s += bfhi(av[j]) * bfhi(bv[j]); }
    }
    return s;
}
__device__ __forceinline__ void dot2_bf16(const bf16* a, const bf16* b0, const bf16* b1, int K, float& r0, float& r1) {
    float s0 = 0.f, s1 = 0.f;
    for (int k = 0; k < K; k += 8) {
        const v4u av = *(const v4u*)(a + k), bv = *(const v4u*)(b0 + k), cv = *(const v4u*)(b1 + k);
#pragma unroll
        for (int j = 0; j < 4; ++j) { const float al = bflo(av[j]), ah = bfhi(av[j]);
            s0 += al * bflo(bv[j]); s0 += ah * bfhi(bv[j]); s1 += al * bflo(cv[j]); s1 += ah * bfhi(cv[j]); }
    }
    r0 = s0; r1 = s1;
}
__device__ __forceinline__ void conv_wt(const Frame& F, const float* src, int ldN, int srccol0, bf16* dst, int K, int nrows, int dstrow0) {
    const int total = nrows * (K / 8);
    for (int i = F.gtid; i < total; i += F.NT) {
        const int n = i % nrows, k8 = i / nrows; const float* s = src + (size_t)(k8 * 8) * ldN + srccol0 + n;
        v4u o; o.x = pk2(s[0], s[(size_t)ldN]); o.y = pk2(s[(size_t)2 * ldN], s[(size_t)3 * ldN]); o.z = pk2(s[(size_t)4 * ldN], s[(size_t)5 * ldN]); o.w = pk2(s[(size_t)6 * ldN], s[(size_t)7 * ldN]);
        *(v4u*)(dst + (size_t)(dstrow0 + n) * K + k8 * 8) = o;
    }
}
__device__ __forceinline__ int win_segbase(int s) {
    if (s < 16) return 128 * s;
    const int pn = s >> 1, half = s & 1, t = (pn - 8) >> 3, pp = (pn - 8) & 7;
    const int first = t == 0 ? C_CC : (t == 1 ? C_GA : C_GB), second = t == 0 ? C_CX : (t == 1 ? C_GO : C_CBR);
    return (half == 0 ? first : second) + 128 * pp;
}

__device__ __forceinline__ int modrow(int m);
namespace pg8 {
#define PG8_LAS __attribute__((address_space(3)))
typedef unsigned short bf16_t;
typedef short bf16x8 __attribute__((ext_vector_type(8)));
typedef float f32x4 __attribute__((ext_vector_type(4)));
typedef unsigned u32x4 __attribute__((ext_vector_type(4)));
constexpr int BM = 256, BK = 64, HALF = 128, HTB = HALF * BK * 2  , STAGE_BYTES = 8 * HTB, NXCD = 8, WGM = 8;

__host__ __device__ __forceinline__ int lds_byte(int r, int c) { const int st = (r >> 4) * 2 + (c >> 5), rr = r & 15, cc = c & 31, ob = rr * 64 + cc * 2; return st * 1024 + (ob ^ (((ob >> 9) & 1) << 5)); }
__host__ __device__ __forceinline__ void stage_rc(int b, int& R, int& C) { const int st = b / 1024, sb = b % 1024, swz = sb ^ (((sb >> 9) & 1) << 5); R = (st >> 1) * 16 + swz / 64; C = (st & 1) * 32 + (swz % 64) / 2; }
__host__ __device__ __forceinline__ int perm32(int rho) { const int n = rho >> 4, i = rho & 15; return 8 * (i >> 2) + 4 * n + (i & 3); }

struct Unit { int pm, pn, tr; };
struct Gemm { const bf16_t* A; const bf16_t* Bt; int M, N, K; };

struct StaticOrder {
    int nM, nN, nwg, G, c;
    __host__ __device__ void init(int M, int N, int G_, int c_) { nM = M / BM; nN = N / BM; nwg = nM * nN; G = G_; c = c_; }
    __host__ __device__ bool next(int i, Unit& u) const {
        const long L = (long)i * G + c; if (L >= nwg) return false;
        int wgid = (int)L; { const int q = nwg / NXCD, r = nwg % NXCD, xcd = wgid % NXCD, off = wgid / NXCD; wgid = (xcd < r ? xcd * (q + 1) : r * (q + 1) + (xcd - r) * q) + off; }
        const int nig = WGM * nN, gid = wgid / nig, fm = gid * WGM, gsz = (nM - fm) < WGM ? (nM - fm) : WGM;
        u.pm = fm + ((wgid % nig) % gsz); u.pn = (wgid % nig) / gsz; u.tr = 0; return true;
    }
    __device__ __forceinline__ const char* abase(const Gemm& g, const Unit& u, size_t tstep) const { return (const char*)g.A + (size_t)u.pm * tstep; }
    __device__ __forceinline__ const char* bbase(const Gemm& g, const Unit& u, size_t tstep) const { return (const char*)g.Bt + (size_t)u.pn * tstep; }
    __device__ __forceinline__ void a_ready(const Unit&) const {}
    __device__ __forceinline__ void done(const Unit&) const {}
};

__device__ __forceinline__ unsigned cvt_pk_bf16(float lo, float hi) { unsigned r; asm volatile("v_cvt_pk_bf16_f32 %0, %1, %2" : "=v"(r) : "v"(lo), "v"(hi)); return r; }
typedef float f32x2 __attribute__((ext_vector_type(2)));

struct InProjOrder {
    StaticOrder a, b; int G, c;
    __device__ void init(int G_, int c_) { G = G_; c = c_; a.init(12288, 6144, G_, c_); b.init(2048, 12288, G_, c_); }
    __device__ bool next(int i, Unit& u) const {
        const long L = (long)i * G + c;
        if (L < a.nwg) { StaticOrder t = a; t.c = (int)L; t.G = 0; const bool ok = t.next(0, u); u.pn += 8; u.tr = 0; return ok; }
        const long L2 = L - a.nwg; if (L2 >= b.nwg) return false;
        StaticOrder t = b; t.c = (int)L2; t.G = 0; const bool ok = t.next(0, u); u.tr = 1; return ok;
    }
    __device__ __forceinline__ const char* abase(const Gemm& g, const Unit& u, size_t tstep) const { return (const char*)(u.tr ? g.Bt : g.A) + (size_t)u.pm * tstep; }
    __device__ __forceinline__ const char* bbase(const Gemm& g, const Unit& u, size_t tstep) const { return (const char*)(u.tr ? g.A : g.Bt) + (size_t)u.pn * tstep; }
    __device__ __forceinline__ void a_ready(const Unit&) const {}
    __device__ __forceinline__ void done(const Unit&) const {}
};

struct EpiInProj {
    static constexpr bool PERM = true, AFTER_DRAIN = false;
    bf16_t *QKV, *PP, *A1, *B1;
    __device__ __forceinline__ void operator()(const f32x4 (&acc)[2][2][4][2], const Unit& u, int wr, int wc, int fr, int fq) const {
        const int row0 = u.pm * BM + wr * 64 + fr, cl = wc * 32 + 8 * fq;
        if (u.tr) {
            const float sc = (u.pm < 2) ? QSCALE : 1.f;
#pragma unroll
            for (int ai = 0; ai < 2; ++ai)
#pragma unroll
                for (int m = 0; m < 4; ++m) { bf16_t* rowp = QKV + (size_t)(row0 + ai * HALF + m * 16) * M + u.pn * BM + cl;
#pragma unroll
                    for (int bj = 0; bj < 2; ++bj) { const f32x4 v0 = acc[ai][bj][m][0] * sc, v1 = acc[ai][bj][m][1] * sc;
                        u32x4 w; w.x = cvt_pk_bf16(v0[0], v0[1]); w.y = cvt_pk_bf16(v0[2], v0[3]); w.z = cvt_pk_bf16(v1[0], v1[1]); w.w = cvt_pk_bf16(v1[2], v1[3]);
                        *(u32x4*)(rowp + bj * HALF) = w; } }
        } else {
            const int t = (u.pn - 8) >> 3; bf16_t* base = (t == 0 ? PP : (t == 1 ? A1 : B1)) + 128 * ((u.pn - 8) & 7) + cl;
#pragma unroll
            for (int ai = 0; ai < 2; ++ai)
#pragma unroll
                for (int m = 0; m < 4; ++m) { float r[8];
#pragma unroll
                    for (int n = 0; n < 2; ++n)
#pragma unroll
                        for (int e = 0; e < 4; ++e) { const float x0 = acc[ai][0][m][n][e], x1 = acc[ai][1][m][n][e];
                            r[4 * n + e] = t == 0 ? x0 * x1 : (t == 1 ? sigm(x0) * x1 * sigm(x1) : sigm(x0) * x1); }
                    u32x4 w; w.x = cvt_pk_bf16(r[0], r[1]); w.y = cvt_pk_bf16(r[2], r[3]); w.z = cvt_pk_bf16(r[4], r[5]); w.w = cvt_pk_bf16(r[6], r[7]);
                    *(u32x4*)(base + (size_t)(row0 + ai * HALF + m * 16) * 1024) = w; }
        }
    }
};
struct EpiBf16P {
    static constexpr bool PERM = true, AFTER_DRAIN = false;
    bf16_t* O; int ldc;
    __device__ __forceinline__ void operator()(const f32x4 (&acc)[2][2][4][2], const Unit& u, int wr, int wc, int fr, int fq) const {
        const int row0 = u.pm * BM + wr * 64 + fr, col0 = u.pn * BM + wc * 32 + 8 * fq;
#pragma unroll
        for (int ai = 0; ai < 2; ++ai)
#pragma unroll
            for (int m = 0; m < 4; ++m) { bf16_t* rowp = O + (size_t)(row0 + ai * HALF + m * 16) * ldc + col0;
#pragma unroll
                for (int bj = 0; bj < 2; ++bj) { const f32x4 v0 = acc[ai][bj][m][0], v1 = acc[ai][bj][m][1];
                    u32x4 w; w.x = cvt_pk_bf16(v0[0], v0[1]); w.y = cvt_pk_bf16(v0[2], v0[3]); w.z = cvt_pk_bf16(v1[0], v1[1]); w.w = cvt_pk_bf16(v1[2], v1[3]);
                    *(u32x4*)(rowp + bj * HALF) = w; } }
    }
};
struct EpiResid {
    static constexpr bool PERM = false, AFTER_DRAIN = false;
    const float* xp; const float* xs; float* out; const float* mod_ga;
    __device__ __forceinline__ void operator()(const f32x4 (&acc)[2][2][4][2], const Unit& u, int wr, int wc, int fr, int fq) const {
        const int row0 = u.pm * BM + wr * 64 + fr, col0 = u.pn * BM + wc * 32 + 4 * fq;
        const float* ga = mod_ga + (size_t)modrow(u.pm * BM) * (NMOD * D);
        f32x4 gv[2][2];
#pragma unroll
        for (int bj = 0; bj < 2; ++bj)
#pragma unroll
            for (int n = 0; n < 2; ++n) gv[bj][n] = *(const f32x4*)(ga + col0 + bj * HALF + n * 16);
#pragma unroll
        for (int ai = 0; ai < 2; ++ai)
#pragma unroll
            for (int m = 0; m < 4; ++m) { const int r = row0 + ai * HALF + m * 16;
                const float* bs = xp ? (r < M_P ? xp + (size_t)r * D : xs + (size_t)(r - M_P) * D) : out + (size_t)r * D; float* o = out + (size_t)r * D;
#pragma unroll
                for (int bj = 0; bj < 2; ++bj)
#pragma unroll
                    for (int n = 0; n < 2; ++n) { const int c = col0 + bj * HALF + n * 16; *(f32x4*)(o + c) = *(const f32x4*)(bs + c) + gv[bj][n] * acc[ai][bj][m][n]; } }
    }
};

template <class Epi, class Sched, bool ALIGN_EPI = false, bool SP2 = false>
__device__ __forceinline__ void gemm_phase(PG8_LAS unsigned char* lds, const Gemm g, const Sched& S, const Epi& E) {
    const int tid = threadIdx.x, wid = __builtin_amdgcn_readfirstlane(tid >> 6), lane = tid & 63, wr = wid >> 2, wc = wid & 3, fr = lane & 15, fq = lane >> 4;
    const int K = g.K, nt = K / BK;
    unsigned voffA[2], voffB[2];
#pragma unroll
    for (int i = 0; i < 2; ++i) { int R, C; stage_rc(tid * 16 + i * 8192, R, C); const int Rb = Epi::PERM ? ((R & ~31) + perm32(R & 31)) : R;
        voffA[i] = (unsigned)(R * K + C) * 2u; voffB[i] = (unsigned)(Rb * K + C) * 2u; }
    const size_t kstep = (size_t)(BK * 2);
    const size_t hstep = (size_t)HALF * K * 2;
    const size_t tstep = 2 * hstep;
    const unsigned ldsw = (unsigned)wid * 1024u;
    const int aoff = lds_byte(wr * 64 + fr, fq * 8), boff = lds_byte(wc * 32 + fr, fq * 8);
#define PG8_SA(b, h) (((b) * 2 + (h)) * HTB)
#define PG8_SB(b, h) ((4 + (b) * 2 + (h)) * HTB)
#define PG8_STAGE(bufoff, gbase, voff) do { _Pragma("unroll") for (int _i = 0; _i < 2; ++_i) \
        __builtin_amdgcn_global_load_lds((const unsigned*)((const char*)(gbase) + (voff)[_i]), (PG8_LAS unsigned*)(lds + (bufoff) + ldsw + _i * 8192), 16, 0, 0); } while (0)
#define PG8_LDA(dst, b, h) do { _Pragma("unroll") for (int m = 0; m < 4; ++m) _Pragma("unroll") for (int k = 0; k < 2; ++k) dst[m][k] = *(const PG8_LAS bf16x8*)(lds + PG8_SA(b, h) + aoff + m * 2048 + k * 1024); } while (0)
#define PG8_LDB(dst, b, h) do { _Pragma("unroll") for (int n = 0; n < 2; ++n) _Pragma("unroll") for (int k = 0; k < 2; ++k) dst[n][k] = *(const PG8_LAS bf16x8*)(lds + PG8_SB(b, h) + boff + n * 2048 + k * 1024); } while (0)
#define PG8_MMA(ai, bj, At, Bt) do { __builtin_amdgcn_s_setprio(1); _Pragma("unroll") for (int m = 0; m < 4; ++m) _Pragma("unroll") for (int n = 0; n < 2; ++n) _Pragma("unroll") for (int k = 0; k < 2; ++k) \
        acc[ai][bj][m][n] = __builtin_amdgcn_mfma_f32_16x16x32_bf16(Bt[n][k], At[m][k], acc[ai][bj][m][n], 0, 0, 0); __builtin_amdgcn_s_setprio(0); } while (0)
#define PG8_WAIT_V(n) asm volatile("s_waitcnt vmcnt(" #n ")" ::: "memory")
#define PG8_WAIT_L(n) asm volatile("s_waitcnt lgkmcnt(" #n ")" ::: "memory")
#define PG8_BAR __builtin_amdgcn_s_barrier()
#define PG8_SCHED __builtin_amdgcn_sched_barrier(0)
    Unit cur, nxt; int ui = 0;
    if (!S.next(0, cur)) return;
    f32x4 acc[2][2][4][2];
#pragma unroll
    for (int a = 0; a < 2; ++a)
#pragma unroll
        for (int b = 0; b < 2; ++b)
#pragma unroll
            for (int m = 0; m < 4; ++m)
#pragma unroll
                for (int n = 0; n < 2; ++n) acc[a][b][m][n] = (f32x4){0.f, 0.f, 0.f, 0.f};
    bf16x8 At[4][2], B0[2][2], B1[2][2];
    const char* cA = S.abase(g, cur, tstep); const char* cB = S.bbase(g, cur, tstep);
    S.a_ready(cur);
    if constexpr (SP2) {
        PG8_STAGE(PG8_SB(0, 0), cB, voffB); PG8_STAGE(PG8_SB(0, 1), cB + hstep, voffB); PG8_STAGE(PG8_SA(0, 0), cA, voffA); PG8_STAGE(PG8_SA(0, 1), cA + hstep, voffA);
        if (wr == 1) PG8_BAR;
        PG8_WAIT_V(2); PG8_BAR;
        PG8_STAGE(PG8_SB(1, 0), cB + kstep, voffB); PG8_STAGE(PG8_SA(1, 0), cA + kstep, voffA); PG8_STAGE(PG8_SB(1, 1), cB + hstep + kstep, voffB);
        PG8_WAIT_V(6); PG8_BAR;
    } else {
        PG8_STAGE(PG8_SB(0, 0), cB, voffB); PG8_STAGE(PG8_SA(0, 0), cA, voffA); PG8_STAGE(PG8_SB(0, 1), cB + hstep, voffB); PG8_STAGE(PG8_SA(0, 1), cA + hstep, voffA);
        if (wr == 1) PG8_BAR;
        PG8_WAIT_V(4); PG8_BAR;
        PG8_STAGE(PG8_SB(1, 0), cB + kstep, voffB); PG8_STAGE(PG8_SA(1, 0), cA + kstep, voffA); PG8_STAGE(PG8_SB(1, 1), cB + hstep + kstep, voffB);
        PG8_WAIT_V(6); PG8_BAR;
    }
    for (;;) {
        const bool has_next = S.next(ui + 1, nxt);
        const char* nA = has_next ? S.abase(g, nxt, tstep) : cA; const char* nB = has_next ? S.bbase(g, nxt, tstep) : cB;
        for (int t = 0; t < nt; t += 2) {
            const bool last = (t == nt - 2);
            const char* a1 = cA + (size_t)(t + 1) * kstep;
            const char* a2 = last ? nA : cA + (size_t)(t + 2) * kstep; const char* b2 = last ? nB : cB + (size_t)(t + 2) * kstep;
            const char* a3 = a2 + kstep; const char* b3 = b2 + kstep;
            if (last && has_next) S.a_ready(nxt);
            if constexpr (SP2) {
            PG8_LDB(B0, 0, 0); PG8_LDB(B1, 0, 1); PG8_SCHED; PG8_LDA(At, 0, 0); PG8_STAGE(PG8_SA(1, 1), a1 + hstep, voffA);
            PG8_WAIT_V(8); PG8_WAIT_L(0); PG8_BAR; PG8_MMA(0, 0, At, B0); PG8_MMA(0, 1, At, B1); PG8_BAR; PG8_SCHED;
            PG8_LDA(At, 0, 1); PG8_STAGE(PG8_SB(0, 0), b2, voffB); PG8_STAGE(PG8_SB(0, 1), b2 + hstep, voffB); PG8_STAGE(PG8_SA(0, 0), a2, voffA);
            PG8_WAIT_V(8); PG8_WAIT_L(0); PG8_BAR; PG8_MMA(1, 0, At, B0); PG8_MMA(1, 1, At, B1); PG8_BAR; PG8_SCHED;
            PG8_LDB(B0, 1, 0); PG8_LDB(B1, 1, 1); PG8_SCHED; PG8_LDA(At, 1, 0); PG8_STAGE(PG8_SA(0, 1), a2 + hstep, voffA);
            PG8_WAIT_V(8); PG8_WAIT_L(0); PG8_BAR; PG8_MMA(0, 0, At, B0); PG8_MMA(0, 1, At, B1); PG8_BAR; PG8_SCHED;
            PG8_LDA(At, 1, 1); PG8_STAGE(PG8_SB(1, 0), b3, voffB); PG8_STAGE(PG8_SB(1, 1), b3 + hstep, voffB); PG8_STAGE(PG8_SA(1, 0), a3, voffA);
            PG8_WAIT_V(8); PG8_WAIT_L(0); PG8_BAR; PG8_MMA(1, 0, At, B0); PG8_MMA(1, 1, At, B1); PG8_BAR; PG8_SCHED;
            } else {
            PG8_LDB(B0, 0, 0); PG8_SCHED; PG8_LDA(At, 0, 0); PG8_STAGE(PG8_SA(1, 1), a1 + hstep, voffA);
            PG8_WAIT_L(8); PG8_BAR; PG8_WAIT_L(0); PG8_MMA(0, 0, At, B0); PG8_BAR; PG8_SCHED;
            PG8_LDB(B1, 0, 1); PG8_STAGE(PG8_SB(0, 0), b2, voffB);
            PG8_BAR; PG8_WAIT_L(0); PG8_MMA(0, 1, At, B1); PG8_BAR;
            PG8_LDA(At, 0, 1); PG8_STAGE(PG8_SA(0, 0), a2, voffA);
            PG8_BAR; PG8_WAIT_L(0); PG8_MMA(1, 0, At, B0); PG8_BAR; PG8_SCHED;
            PG8_STAGE(PG8_SB(0, 1), b2 + hstep, voffB);
            PG8_WAIT_V(6); PG8_BAR; PG8_MMA(1, 1, At, B1); PG8_BAR;
            PG8_LDB(B0, 1, 0); PG8_SCHED; PG8_LDA(At, 1, 0); PG8_STAGE(PG8_SA(0, 1), a2 + hstep, voffA);
            PG8_WAIT_L(8); PG8_BAR; PG8_WAIT_L(0); PG8_MMA(0, 0, At, B0); PG8_BAR; PG8_SCHED;
            PG8_LDB(B1, 1, 1); PG8_STAGE(PG8_SB(1, 0), b3, voffB);
            PG8_BAR; PG8_WAIT_L(0); PG8_MMA(0, 1, At, B1); PG8_BAR;
            PG8_LDA(At, 1, 1); PG8_STAGE(PG8_SA(1, 0), a3, voffA);
            PG8_BAR; PG8_WAIT_L(0); PG8_MMA(1, 0, At, B0); PG8_BAR; PG8_SCHED;
            PG8_STAGE(PG8_SB(1, 1), b3 + hstep, voffB);
            PG8_WAIT_V(6); PG8_BAR; PG8_MMA(1, 1, At, B1); PG8_BAR;
            }
        }
        if constexpr (ALIGN_EPI) { if (wr == 0) PG8_BAR; }
        if constexpr (!Epi::AFTER_DRAIN) { E(acc, cur, wr, wc, fr, fq); S.done(cur); }
        if (!has_next) break;
#pragma unroll
        for (int a = 0; a < 2; ++a)
#pragma unroll
            for (int b = 0; b < 2; ++b)
#pragma unroll
                for (int m = 0; m < 4; ++m)
#pragma unroll
                    for (int n = 0; n < 2; ++n) acc[a][b][m][n] = (f32x4){0.f, 0.f, 0.f, 0.f};
        cur = nxt; cA = nA; cB = nB; ++ui;
        if constexpr (ALIGN_EPI) { if (wr == 1) PG8_BAR; }
    }
    PG8_WAIT_V(0);
    if constexpr (!ALIGN_EPI) { if (wr == 0) PG8_BAR; }
    PG8_BAR;
    if constexpr (Epi::AFTER_DRAIN) { E.fused(acc, cur, wr, wc, fr, fq, lds, wid, lane); S.done(cur); }
#undef PG8_SA
#undef PG8_SB
#undef PG8_STAGE
#undef PG8_LDA
#undef PG8_LDB
#undef PG8_MMA
#undef PG8_WAIT_V
#undef PG8_WAIT_L
#undef PG8_BAR
#undef PG8_SCHED
}
}


__device__ __forceinline__ void p0_prologue(Frame& F) {
    if (blockIdx.x < 96) {
        LAS float* sl = (LAS float*)F.lds;
        LAS float* red = sl + 5 * 1024;
        for (int i = F.tid; i < 5 * 1024; i += NTHR) { const int r = i >> 10, k = i & 1023; const float v = (r == 0) ? F.c_ctx[k] : F.c[(r - 1) * 1024 + k]; sl[i] = v * sigm(v); }
        __syncthreads();
        const int cc = F.tid & 63, kc = F.tid >> 6, col = blockIdx.x * 64 + cc;
        float a0 = 0.f, a1 = 0.f, a2 = 0.f, a3 = 0.f, a4 = 0.f;
#pragma unroll 8
        for (int k = kc * 128; k < kc * 128 + 128; ++k) { const float w = F.w_ada[(size_t)k * (NMOD * D) + col];
            a0 += sl[k] * w; a1 += sl[1024 + k] * w; a2 += sl[2048 + k] * w; a3 += sl[3072 + k] * w; a4 += sl[4096 + k] * w; }
        red[(kc * 5 + 0) * 64 + cc] = a0; red[(kc * 5 + 1) * 64 + cc] = a1; red[(kc * 5 + 2) * 64 + cc] = a2; red[(kc * 5 + 3) * 64 + cc] = a3; red[(kc * 5 + 4) * 64 + cc] = a4;
        __syncthreads();
        if (F.tid < 320) { const int r = F.tid >> 6; float s = F.b_ada[blockIdx.x * 64 + cc];
#pragma unroll
            for (int q = 0; q < 8; ++q) s += red[(q * 5 + r) * 64 + cc];
            F.MOD[r * (NMOD * D) + blockIdx.x * 64 + cc] = s; }
        __syncthreads();
    }
    if (P0_FAST) return;
    for (int s = 0; s < 64; ++s) conv_wt(F, F.w_in, IN_DIM, win_segbase(s), F.WIN, D, 128, 128 * s);
    conv_wt(F, F.w_in, IN_DIM, C_CF, F.WC, D, 32, 0);
    conv_wt(F, F.w_out, D, 0, F.WOUT, D, D, 0);
    conv_wt(F, F.w_up, FF, 0, F.WUG, D, FF, 0);
    conv_wt(F, F.w_gate, FF, 0, F.WUG, D, FF, FF);
    conv_wt(F, F.w_down, D, 0, F.WDN, FF, D, 0);
}

__device__ __forceinline__ void norm_mod_row(const float* xr_, const float* g, const float* sc, const float* sh, bf16* orow, int lane) {
    const f32x4* xr = (const f32x4*)xr_ + lane;
    f32x4 v[4]; float s = 0.f;
#pragma unroll
    for (int j = 0; j < 4; ++j) { v[j] = xr[64 * j]; s += (v[j].x * v[j].x + v[j].y * v[j].y) + (v[j].z * v[j].z + v[j].w * v[j].w); }
    const float rstd = 1.0f / sqrtf(wave_sum(s) * (1.f / D) + EPS);
#pragma unroll
    for (int j = 0; j < 4; ++j) {
        const int c0 = 4 * lane + 256 * j;
        const f32x4 gg = *(const f32x4*)(g + c0), s1 = *(const f32x4*)(sc + c0), h1 = *(const f32x4*)(sh + c0);
        const f32x4 y = (v[j] * rstd) * gg * (s1 + 1.0f) + h1;
        v2u o; o.x = pk2(y.x, y.y); o.y = pk2(y.z, y.w);
        *(v2u*)(orow + c0) = o;
    }
}
__device__ __forceinline__ void p1_xn(Frame& F) {
    for (int m = F.gw; m < M; m += F.NGW) { const float* md = F.MOD + modrow(m) * (NMOD * D);
        norm_mod_row(xrow(F, m), F.g1, md + 1 * D, md + 0 * D, F.BUFA + (size_t)m * D, F.lane); }
}

__device__ __forceinline__ void epi_inproj(const Frame& F, int pn, int m, int c, float a0, float a1) {
    if (pn < 8) { const int col = 256 * pn + c, col2 = col + 128;
        F.QKV[(size_t)col * M + m] = (bf16)f2bf(a0 * (col < 512 ? QSCALE : 1.f)); F.QKV[(size_t)col2 * M + m] = (bf16)f2bf(a1 * (col2 < 512 ? QSCALE : 1.f)); }
    else if (pn < 16) F.PP[(size_t)m * 1024 + 128 * (pn - 8) + c] = (bf16)f2bf(a0 * a1);
    else if (pn < 24) F.A1[(size_t)m * 1024 + 128 * (pn - 16) + c] = (bf16)f2bf(sigm(a0) * a1 * sigm(a1));
    else F.B1[(size_t)m * 1024 + 128 * (pn - 24) + c] = (bf16)f2bf(sigm(a0) * a1);
}
__device__ __forceinline__ void p2_inproj_naive(Frame& F) {
    const long total = (long)M * 4096;
    for (long i = F.gtid; i < total; i += F.NT) {
        const int m = (int)(i >> 12), r = (int)(i & 4095), pn = r >> 7, c = r & 127;
        float a0, a1; dot2_bf16(F.BUFA + (size_t)m * D, F.WIN + (size_t)(256 * pn + c) * D, F.WIN + (size_t)(256 * pn + 128 + c) * D, D, a0, a1);
        epi_inproj(F, pn, m, c, a0, a1);
    }
    for (int i = F.gtid; i < M * 32; i += F.NT) { const int m = i >> 5, j = i & 31; F.CODES[i] = dot_bf16(F.BUFA + (size_t)m * D, F.WC + (size_t)j * D, D); }
}

__device__ __forceinline__ void p3_gla_naive(Frame& F) {
    LAS float* qs = (LAS float*)F.lds; LAS float* ks = qs + 64 * 128; LAS float* eg = ks + 64 * 128;
    for (int u = blockIdx.x; u < 288; u += F.G) {
        int b, h, dir, L, row0; const float* s0 = nullptr;
        if (u < 32) { b = u >> 3; h = (u >> 1) & 3; dir = u & 1; L = L_S; row0 = M_P + b * L_S; s0 = (dir ? F.st_b : F.st_f) + (size_t)(b * NH + h) * HK * HV; }
        else { const int up = u - 32; b = up >> 3; h = (up >> 1) & 3; dir = up & 1; L = L_P; row0 = b * L_P; }
        const float* wgk = dir ? F.wgk_b : F.wgk_f; const float* bgk = dir ? F.bgk_b : F.bgk_f;
        bf16* O = dir ? F.OB : F.OF;
        const int v = F.tid & 255;
        float S[HK];
#pragma unroll
        for (int d = 0; d < HK; ++d) S[d] = s0 ? s0[d * HV + v] : 0.f;
        for (int n = 0; n < L / 64; ++n) {
            __syncthreads();
            for (int i = F.tid; i < 64 * 128; i += NTHR) {
                const int j = i >> 7, d = i & 127, t = n * 64 + j, m = row0 + (dir ? L - 1 - t : t);
                qs[i] = bf2f(F.QKV[(size_t)(h * HK + d) * M + m]); ks[i] = bf2f(F.QKV[(size_t)(KD + h * HK + d) * M + m]);
                float z = bgk[h * HK + d];
#pragma unroll
                for (int r = 0; r < GR; ++r) z += F.CODES[m * 32 + dir * 16 + r] * wgk[r * KD + h * HK + d];
                eg[i] = expf(logsig(z) * (1.0f / 16.0f));
            }
            __syncthreads();
            if (F.tid < 256) {
                for (int j = 0; j < 64; ++j) {
                    const int t = n * 64 + j, m = row0 + (dir ? L - 1 - t : t);
                    const float vv = bf2f(F.QKV[(size_t)(2 * KD + h * HV + v) * M + m]); float o = 0.f;
#pragma unroll
                    for (int d = 0; d < HK; ++d) { S[d] = S[d] * eg[j * 128 + d] + ks[j * 128 + d] * vv; o += qs[j * 128 + d] * S[d]; }
                    O[(size_t)m * VD + h * HV + v] = (bf16)f2bf(o);
                }
            }
        }
        if (u >= 32 && F.tid < 256) { float* so = F.out + (size_t)M * D + (size_t)dir * (32 * NH * HK * HV) + (size_t)(b * NH + h) * HK * HV;
#pragma unroll
            for (int d = 0; d < HK; ++d) so[d * HV + v] = S[d]; }
    }
    __syncthreads();
}

__device__ __forceinline__ f32x4 ld4bf(const bf16* p) { const v2u w = *(const v2u*)p; return (f32x4){bflo(w.x), bfhi(w.x), bflo(w.y), bfhi(w.y)}; }
__device__ __forceinline__ void p3b_mixprep(Frame& F) {
    for (int it = F.gw; it < M * NH; it += F.NGW) {
        const int m = it >> 2, h = it & 3, c0 = h * HV + 4 * F.lane;
        const int L = m < M_P ? L_P : L_S, t = m < M_P ? (m & (L_P - 1)) : ((m - M_P) & (L_S - 1));
        const size_t off = (size_t)m * VD + c0;
        const f32x4 o = ld4bf(F.OF + off) + ld4bf(F.OB + off);
        const float ss = wave_sum((o.x * o.x + o.y * o.y) + (o.z * o.z + o.w * o.w));
        const float rstd = 1.0f / sqrtf(ss * (1.f / HV) + EPS);
        const f32x4 on = (o * rstd) * *(const f32x4*)(F.gla_g + 4 * F.lane);
        const f32x4 z4 = (f32x4){0.f, 0.f, 0.f, 0.f};
        const f32x4 p0 = ld4bf(F.PP + off), pm = t > 0 ? ld4bf(F.PP + off - VD) : z4, pp = t < L - 1 ? ld4bf(F.PP + off + VD) : z4;
        const f32x4 cv = *(const f32x4*)(F.cmw + c0) * pm + *(const f32x4*)(F.cmw + D + c0) * p0 + *(const f32x4*)(F.cmw + 2 * D + c0) * pp;
        const f32x4 mx = ld4bf(F.A1 + off) * on + ld4bf(F.B1 + off) * cv;
        v2u w; w.x = pk2(mx.x, mx.y); w.y = pk2(mx.z, mx.w);
        *(v2u*)(F.BUFB + off) = w;
    }
}

__device__ __forceinline__ void p4a_naive(Frame& F) {
    for (int i = F.gtid; i < M * D; i += F.NT) { const int m = i >> 10, n = i & 1023;
        const float acc = dot_bf16(F.BUFB + (size_t)m * D, F.WOUT + (size_t)n * D, D);
        F.out[i] = xrow(F, m)[n] + F.MOD[modrow(m) * (NMOD * D) + 2 * D + n] * acc; }
}
__device__ __forceinline__ void p4b_norm2(Frame& F) {
    for (int m = F.gw; m < M; m += F.NGW) { const float* md = F.MOD + modrow(m) * (NMOD * D);
        norm_mod_row(F.out + (size_t)m * D, F.g2, md + 4 * D, md + 3 * D, F.BUFA + (size_t)m * D, F.lane); }
}
__device__ __forceinline__ void p5_naive(Frame& F) {
    const long total = (long)M * FF2;
    for (long i = F.gtid; i < total; i += F.NT) { const int m = (int)(i / FF2), n = (int)(i % FF2);
        F.UG[i] = (bf16)f2bf(dot_bf16(F.BUFA + (size_t)m * D, F.WUG + (size_t)n * D, D)); }
}
__device__ __forceinline__ void p5b_act(Frame& F) {
    const int total = M * (FF / 8);
    for (int i = F.gtid; i < total; i += F.NT) {
        const int m = i / (FF / 8), f0 = 8 * (i % (FF / 8));
        float acc[8];
        { const f32x4 b0 = *(const f32x4*)(F.fcb + f0), b1 = *(const f32x4*)(F.fcb + f0 + 4); acc[0] = b0.x; acc[1] = b0.y; acc[2] = b0.z; acc[3] = b0.w; acc[4] = b1.x; acc[5] = b1.y; acc[6] = b1.z; acc[7] = b1.w; }
        int y, x, H, W;
        if (m < M_P) { y = 0; x = m & (L_P - 1); H = 1; W = L_P; } else { const int p = (m - M_P) & (L_S - 1); y = p >> 6; x = p & 63; H = 16; W = 64; }
#pragma unroll
        for (int ky = 0; ky < 3; ++ky)
#pragma unroll
            for (int kx = 0; kx < 3; ++kx) {
                const int yy = y + ky - 1, xx = x + kx - 1;
                if (yy >= 0 && yy < H && xx >= 0 && xx < W) {
                    const int m2 = m + (ky - 1) * W + (kx - 1);
                    const v4u uv = *(const v4u*)(F.UG + (size_t)m2 * FF2 + f0);
                    const float* w = F.fcw + (size_t)(ky * 3 + kx) * FF + f0; const f32x4 w0 = *(const f32x4*)w, w1 = *(const f32x4*)(w + 4);
                    acc[0] += w0.x * bflo(uv.x); acc[1] += w0.y * bfhi(uv.x); acc[2] += w0.z * bflo(uv.y); acc[3] += w0.w * bfhi(uv.y);
                    acc[4] += w1.x * bflo(uv.z); acc[5] += w1.y * bfhi(uv.z); acc[6] += w1.z * bflo(uv.w); acc[7] += w1.w * bfhi(uv.w);
                }
            }
        const v4u gv = *(const v4u*)(F.UG + (size_t)m * FF2 + FF + f0);
        float r[8];
        r[0] = acc[0] * sigm(acc[0]) * bflo(gv.x); r[1] = acc[1] * sigm(acc[1]) * bfhi(gv.x); r[2] = acc[2] * sigm(acc[2]) * bflo(gv.y); r[3] = acc[3] * sigm(acc[3]) * bfhi(gv.y);
        r[4] = acc[4] * sigm(acc[4]) * bflo(gv.z); r[5] = acc[5] * sigm(acc[5]) * bfhi(gv.z); r[6] = acc[6] * sigm(acc[6]) * bflo(gv.w); r[7] = acc[7] * sigm(acc[7]) * bfhi(gv.w);
        v4u o; o.x = pk2(r[0], r[1]); o.y = pk2(r[2], r[3]); o.z = pk2(r[4], r[5]); o.w = pk2(r[6], r[7]);
        *(v4u*)(F.ACT + (size_t)m * FF + f0) = o;
    }
}
__device__ __forceinline__ void p6a_naive(Frame& F) {
    for (int i = F.gtid; i < M * D; i += F.NT) { const int m = i >> 10, n = i & 1023;
        const float acc = dot_bf16(F.ACT + (size_t)m * FF, F.WDN + (size_t)n * FF, FF);
        F.out[i] = F.out[i] + F.MOD[modrow(m) * (NMOD * D) + 5 * D + n] * acc; }
}
__device__ __forceinline__ void p6b_normf(Frame& F) {
    for (int m = F.gw; m < M; m += F.NGW) {
        f32x4* xr = (f32x4*)(F.out + (size_t)m * D) + F.lane;
        f32x4 v[4]; float s = 0.f;
#pragma unroll
        for (int j = 0; j < 4; ++j) { v[j] = xr[64 * j]; s += (v[j].x * v[j].x + v[j].y * v[j].y) + (v[j].z * v[j].z + v[j].w * v[j].w); }
        const float rstd = 1.0f / sqrtf(wave_sum(s) * (1.f / D) + EPS);
#pragma unroll
        for (int j = 0; j < 4; ++j) xr[64 * j] = (v[j] * rstd) * *(const f32x4*)(F.gf + 4 * F.lane + 256 * j);
    }
}

namespace gla {
typedef float f32x16 __attribute__((ext_vector_type(16)));
typedef short bf16x8 __attribute__((ext_vector_type(8)));
constexpr int P_TD = 272, P_DT = 144;
constexpr int L_QR = 0, L_KR = L_QR + 64 * P_TD, L_KRT = L_KR + 64 * P_TD, L_VT = L_KRT + 128 * P_DT, L_A = L_VT + 256 * P_DT, L_T = L_A + 64 * P_DT, L_E = L_T + 1024, L_END = L_E + 1024;
static_assert(L_END <= 131072, "gla lds map");
constexpr float L2E = 1.4426950408889634f;
__device__ __forceinline__ unsigned cvtpk(float lo, float hi) { unsigned r; asm volatile("v_cvt_pk_bf16_f32 %0, %1, %2" : "=v"(r) : "v"(lo), "v"(hi)); return r; }
__device__ __forceinline__ bf16x8 mk8(unsigned a, unsigned b, unsigned c, unsigned d) { v4u t; t.x = a; t.y = b; t.z = c; t.w = d; return __builtin_bit_cast(bf16x8, t); }
}
__device__ __forceinline__ void p3_gla_mfma(Frame& F) {
    using namespace gla;
    LAS unsigned char* lds = F.lds;
    const int w = F.wave, l = F.lane, c = l & 31, hf = l >> 5, ib = w >> 2, db = w & 3, dl = 32 * db + c;
    LAS float* Tl = (LAS float*)(lds + L_T); LAS float* El = (LAS float*)(lds + L_E);
    for (int u = blockIdx.x; u < 288; u += F.G) {
        int b, h, dir, L, row0; const float* s0 = nullptr;
        if (u < 32) { b = u >> 3; h = (u >> 1) & 3; dir = u & 1; L = L_S; row0 = M_P + b * L_S; s0 = (dir ? F.st_b : F.st_f) + (size_t)(b * NH + h) * HK * HV; }
        else { const int up = u - 32; b = up >> 3; h = (up >> 1) & 3; dir = up & 1; L = L_P; row0 = b * L_P; }
        const float* wgk = dir ? F.wgk_b : F.wgk_f; const float* bgk = dir ? F.bgk_b : F.bgk_f;
        bf16* O = dir ? F.OB : F.OF;
        int lane_s = 4 * hf * HV + 32 * w + c; asm volatile("" : "+v"(lane_s));
        const int dcol = h * HK + dl;
        float wB[8];
#pragma unroll
        for (int s = 0; s < 8; ++s) wB[s] = wgk[(2 * s + hf) * KD + dcol];
        const float bz = bgk[dcol];
        f32x16 S[4];
#pragma unroll
        for (int p = 0; p < 4; ++p)
#pragma unroll
            for (int r = 0; r < 16; ++r) S[p][r] = s0 ? (s0 + (32 * p + (r & 3) + 8 * (r >> 2)) * HV)[lane_s] : 0.f;
        const int nch = L / 64;
        for (int n = 0; n < nch; ++n) {
            const int ne = dir ? nch - 1 - n : n, m0 = row0 + 64 * ne;
            float cA[8];
            { const float* cp = F.CODES + (size_t)(m0 + 32 * ib + c) * 32 + dir * 16 + hf;
#pragma unroll
              for (int s = 0; s < 8; ++s) cA[s] = cp[2 * s]; }
            v2u qraw[4], kraw[4];
            { const bf16* qp = F.QKV + (size_t)dcol * M + m0 + 32 * ib + 4 * hf; const bf16* kp = qp + (size_t)KD * M;
#pragma unroll
              for (int q4 = 0; q4 < 4; ++q4) { qraw[q4] = *(const v2u*)(qp + 8 * q4); kraw[q4] = *(const v2u*)(kp + 8 * q4); } }
            v4u vreg[4];
            { const bf16* vp = F.QKV + (size_t)(2 * KD + h * HV + (F.tid >> 1)) * M + m0 + 32 * (F.tid & 1);
#pragma unroll
              for (int j = 0; j < 4; ++j) vreg[j] = *(const v4u*)(vp + 8 * j); }
            f32x16 z;
#pragma unroll
            for (int r = 0; r < 16; ++r) z[r] = bz;
#pragma unroll
            for (int s = 0; s < 8; ++s) z = __builtin_amdgcn_mfma_f32_32x32x2f32(cA[s], wB[s], z, 0, 0, 0);
            float Bl[16]; float Tb;
            {
                float p[16], sg[4], tg[4];
#pragma unroll
                for (int r = 0; r < 16; ++r) { const float zz = z[r]; p[r] = (fminf(zz, 0.f) * L2E - __builtin_amdgcn_logf(1.f + __builtin_amdgcn_exp2f(-fabsf(zz) * L2E))) * 0.0625f; }
                if (!dir) {
#pragma unroll
                    for (int q4 = 0; q4 < 4; ++q4) { p[4 * q4 + 1] += p[4 * q4]; p[4 * q4 + 2] += p[4 * q4 + 1]; p[4 * q4 + 3] += p[4 * q4 + 2]; sg[q4] = p[4 * q4 + 3]; }
                } else {
#pragma unroll
                    for (int q4 = 0; q4 < 4; ++q4) { p[4 * q4 + 2] += p[4 * q4 + 3]; p[4 * q4 + 1] += p[4 * q4 + 2]; p[4 * q4] += p[4 * q4 + 1]; sg[q4] = p[4 * q4]; }
                }
#pragma unroll
                for (int q4 = 0; q4 < 4; ++q4) tg[q4] = __shfl_xor(sg[q4], 32);
                float off[4], run = 0.f;
                if (!dir) {
#pragma unroll
                    for (int q4 = 0; q4 < 4; ++q4) { off[q4] = run + (hf ? tg[q4] : 0.f); run += sg[q4] + tg[q4]; }
                } else {
#pragma unroll
                    for (int q4 = 3; q4 >= 0; --q4) { off[q4] = run + (hf ? 0.f : tg[q4]); run += sg[q4] + tg[q4]; }
                }
                Tb = run;
#pragma unroll
                for (int r = 0; r < 16; ++r) Bl[r] = p[r] + off[r >> 2];
            }
            if (hf == 0) Tl[ib * 128 + dl] = Tb;
            __syncthreads();
            {
                const float T0 = Tl[dl], T1 = Tl[128 + dl];
                const float Tfirst = dir ? T1 : T0, Tsecond = dir ? T0 : T1;
                const bool first = dir ? (ib == 1) : (ib == 0);
                const float sub = first ? Tfirst : 0.f;
#pragma unroll
                for (int q4 = 0; q4 < 4; ++q4) {
                    const float qv[4] = {bflo(qraw[q4].x), bfhi(qraw[q4].x), bflo(qraw[q4].y), bfhi(qraw[q4].y)};
                    const float kv[4] = {bflo(kraw[q4].x), bfhi(kraw[q4].x), bflo(kraw[q4].y), bfhi(kraw[q4].y)};
                    float qr_[4], kr_[4];
#pragma unroll
                    for (int e = 0; e < 4; ++e) { const float x = Bl[4 * q4 + e] - sub; qr_[e] = qv[e] * __builtin_amdgcn_exp2f(x); kr_[e] = kv[e] * __builtin_amdgcn_exp2f(-x); }
                    const unsigned q01 = cvtpk(qr_[0], qr_[1]), q23 = cvtpk(qr_[2], qr_[3]), k01 = cvtpk(kr_[0], kr_[1]), k23 = cvtpk(kr_[2], kr_[3]);
                    const int tok = 32 * ib + 8 * q4 + 4 * hf;
                    LAS unsigned char* qd = lds + L_QR + tok * P_TD + 2 * dl; LAS unsigned char* kd = lds + L_KR + tok * P_TD + 2 * dl;
                    *(LAS bf16*)(qd) = (bf16)(q01 & 0xffffu); *(LAS bf16*)(qd + P_TD) = (bf16)(q01 >> 16); *(LAS bf16*)(qd + 2 * P_TD) = (bf16)(q23 & 0xffffu); *(LAS bf16*)(qd + 3 * P_TD) = (bf16)(q23 >> 16);
                    *(LAS bf16*)(kd) = (bf16)(k01 & 0xffffu); *(LAS bf16*)(kd + P_TD) = (bf16)(k01 >> 16); *(LAS bf16*)(kd + 2 * P_TD) = (bf16)(k23 & 0xffffu); *(LAS bf16*)(kd + 3 * P_TD) = (bf16)(k23 >> 16);
                    v2u kt; kt.x = k01; kt.y = k23;
                    *(LAS v2u*)(lds + L_KRT + dl * P_DT + 2 * tok) = kt;
                }
                if (ib == 0 && hf == 0) { El[dl] = __builtin_amdgcn_exp2f(Tfirst); El[128 + dl] = __builtin_amdgcn_exp2f(Tsecond); }
                LAS unsigned char* vd = lds + L_VT + (F.tid >> 1) * P_DT + 64 * (F.tid & 1);
#pragma unroll
                for (int j = 0; j < 4; ++j) *(LAS v4u*)(vd + 16 * j) = vreg[j];
            }
            __syncthreads();
            if (w < 4) {
                const int ia = w >> 1, ja = w & 1;
                const bool dead = dir ? (ja < ia) : (ja > ia);
                f32x16 a;
#pragma unroll
                for (int r = 0; r < 16; ++r) a[r] = 0.f;
                if (!dead) {
#pragma unroll
                    for (int ks = 0; ks < 8; ++ks) {
                        const bf16x8 af = *(const LAS bf16x8*)(lds + L_KR + (32 * ja + c) * P_TD + 2 * (16 * ks + 8 * hf));
                        const bf16x8 bq = *(const LAS bf16x8*)(lds + L_QR + (32 * ia + c) * P_TD + 2 * (16 * ks + 8 * hf));
                        a = __builtin_amdgcn_mfma_f32_32x32x16_bf16(af, bq, a, 0, 0, 0);
                    }
                    if (ia == ja) {
#pragma unroll
                        for (int r = 0; r < 16; ++r) { const int j = (r & 3) + 8 * (r >> 2) + 4 * hf; const bool keep = dir ? (j >= c) : (j <= c); a[r] = keep ? a[r] : 0.f; }
                    }
                }
#pragma unroll
                for (int q4 = 0; q4 < 4; ++q4) { v2u t; t.x = cvtpk(a[4 * q4], a[4 * q4 + 1]); t.y = cvtpk(a[4 * q4 + 2], a[4 * q4 + 3]);
                    *(LAS v2u*)(lds + L_A + (32 * ia + c) * P_DT + 2 * (32 * ja + 8 * q4 + 4 * hf)) = t; }
            }
            f32x16 OT[2];
#pragma unroll
            for (int i2 = 0; i2 < 2; ++i2)
#pragma unroll
                for (int r = 0; r < 16; ++r) OT[i2][r] = 0.f;
            __builtin_amdgcn_sched_barrier(0);
#pragma unroll
            for (int p = 0; p < 4; ++p) {
#pragma unroll
                for (int q4 = 0; q4 < 4; ++q4) { const f32x4 e = *(const LAS f32x4*)(El + 32 * p + 8 * q4 + 4 * hf);
                    S[p][4 * q4] *= e.x; S[p][4 * q4 + 1] *= e.y; S[p][4 * q4 + 2] *= e.z; S[p][4 * q4 + 3] *= e.w; }
#pragma unroll
                for (int s = 0; s < 2; ++s) {
                    const bf16x8 sb = mk8(cvtpk(S[p][8 * s], S[p][8 * s + 1]), cvtpk(S[p][8 * s + 2], S[p][8 * s + 3]), cvtpk(S[p][8 * s + 4], S[p][8 * s + 5]), cvtpk(S[p][8 * s + 6], S[p][8 * s + 7]));
#pragma unroll
                    for (int i2 = 0; i2 < 2; ++i2) {
                        const LAS unsigned char* qp = lds + L_QR + (32 * i2 + c) * P_TD + 2 * (32 * p + 16 * s + 4 * hf);
                        const v2u lo = *(const LAS v2u*)qp, hi = *(const LAS v2u*)(qp + 16);
                        OT[i2] = __builtin_amdgcn_mfma_f32_32x32x16_bf16(sb, mk8(lo.x, lo.y, hi.x, hi.y), OT[i2], 0, 0, 0);
                    }
                }
                __builtin_amdgcn_sched_barrier(0);
            }
            __syncthreads();
            {
                bf16x8 vf[4];
#pragma unroll
                for (int ks = 0; ks < 4; ++ks) vf[ks] = *(const LAS bf16x8*)(lds + L_VT + (32 * w + c) * P_DT + 2 * (16 * ks + 8 * hf));
#pragma unroll
                for (int i2 = 0; i2 < 2; ++i2)
#pragma unroll
                    for (int ks = 0; ks < 4; ++ks) { const bf16x8 af = *(const LAS bf16x8*)(lds + L_A + (32 * i2 + c) * P_DT + 2 * (16 * ks + 8 * hf));
                        OT[i2] = __builtin_amdgcn_mfma_f32_32x32x16_bf16(vf[ks], af, OT[i2], 0, 0, 0); }
                __builtin_amdgcn_sched_barrier(0);
#pragma unroll
                for (int p = 0; p < 4; ++p) { __builtin_amdgcn_sched_barrier(0);
#pragma unroll
                    for (int ks = 0; ks < 4; ++ks) { const bf16x8 kf = *(const LAS bf16x8*)(lds + L_KRT + (32 * p + c) * P_DT + 2 * (16 * ks + 8 * hf));
                        S[p] = __builtin_amdgcn_mfma_f32_32x32x16_bf16(kf, vf[ks], S[p], 0, 0, 0); }
#pragma unroll
                    for (int q4 = 0; q4 < 4; ++q4) { const f32x4 e = *(const LAS f32x4*)(El + 128 + 32 * p + 8 * q4 + 4 * hf);
                        S[p][4 * q4] *= e.x; S[p][4 * q4 + 1] *= e.y; S[p][4 * q4 + 2] *= e.z; S[p][4 * q4 + 3] *= e.w; }
                }
                __builtin_amdgcn_sched_barrier(0);
#pragma unroll
                for (int i2 = 0; i2 < 2; ++i2)
#pragma unroll
                    for (int q4 = 0; q4 < 4; ++q4) { v2u t; t.x = cvtpk(OT[i2][4 * q4], OT[i2][4 * q4 + 1]); t.y = cvtpk(OT[i2][4 * q4 + 2], OT[i2][4 * q4 + 3]);
                        *(v2u*)(O + (size_t)(m0 + 32 * i2 + c) * VD + h * HV + 32 * w + 8 * q4 + 4 * hf) = t; }
            }
        }
        if (u >= 32) { float* so = F.out + (size_t)M * D + (size_t)dir * (32 * NH * HK * HV) + (size_t)(b * NH + h) * HK * HV;
#pragma unroll
            for (int p = 0; p < 4; ++p)
#pragma unroll
                for (int r = 0; r < 16; ++r) (so + (32 * p + (r & 3) + 8 * (r >> 2)) * HV)[lane_s] = S[p][r]; }
        __syncthreads();
    }
}

__device__ __forceinline__ void p2_codes_mfma(Frame& F) {
    using namespace gla;
    const int w = F.wave, l = F.lane, c = l & 31, hf = l >> 5;
    LAS float* red = (LAS float*)F.lds;
    for (int rb = blockIdx.x; rb < M / 32; rb += F.G) {
        const bf16* ap = F.BUFA + (size_t)(32 * rb + c) * D + 128 * w + 8 * hf;
        const bf16* bp = F.WC + (size_t)c * D + 128 * w + 8 * hf;
        bf16x8 af[8], bq[8];
#pragma unroll
        for (int s = 0; s < 8; ++s) { af[s] = *(const bf16x8*)(ap + 16 * s); bq[s] = *(const bf16x8*)(bp + 16 * s); }
        f32x16 acc;
#pragma unroll
        for (int r = 0; r < 16; ++r) acc[r] = 0.f;
#pragma unroll
        for (int s = 0; s < 8; ++s) acc = __builtin_amdgcn_mfma_f32_32x32x16_bf16(af[s], bq[s], acc, 0, 0, 0);
#pragma unroll
        for (int r = 0; r < 16; ++r) red[(w * 16 + r) * 64 + l] = acc[r];
        __syncthreads();
#pragma unroll
        for (int k2 = 0; k2 < 2; ++k2) { const int o = F.tid + NTHR * k2, r = o >> 6, ll = o & 63; float s = 0.f;
#pragma unroll
            for (int ww = 0; ww < 8; ++ww) s += red[(ww * 16 + r) * 64 + ll];
            F.CODES[(size_t)(32 * rb + (r & 3) + 8 * (r >> 2) + 4 * (ll >> 5)) * 32 + (ll & 31)] = s; }
        __syncthreads();
    }
}

__device__ __forceinline__ void p0_tr_item(const float* W, int ldN, int srccol, bf16* WT, int K, int dstrow, int k0, LAS float* scr, int lane) {
#pragma unroll 8
    for (int i = 0; i < 32; ++i) { const int kk = 2 * i + (lane >> 5); scr[kk * 33 + (lane & 31)] = W[(size_t)(k0 + kk) * ldN + srccol + (lane & 31)]; }
    asm volatile("s_waitcnt lgkmcnt(0)" ::: "memory");
    const int c8 = lane & 7;
#pragma unroll
    for (int j = 0; j < 4; ++j) { const int n = (lane >> 3) + 8 * j; const LAS float* s = scr + (8 * c8) * 33 + n;
        v4u o; o.x = pk2(s[0 * 33], s[1 * 33]); o.y = pk2(s[2 * 33], s[3 * 33]); o.z = pk2(s[4 * 33], s[5 * 33]); o.w = pk2(s[6 * 33], s[7 * 33]);
        *(v4u*)(WT + (size_t)(dstrow + n) * K + k0 + 8 * c8) = o; }
    asm volatile("s_waitcnt lgkmcnt(0)" ::: "memory");
}
__device__ __forceinline__ void p0_weights_fast(Frame& F) {
    LAS float* scr = (LAS float*)(F.lds + 32768 + F.wave * 8704);
    const int gw = F.vcu * NWAVES + F.wave;
    constexpr int I_IN = 16 * 256, I_C = 16, I_O = 16 * 32, I_U = 16 * 88, I_D = 44 * 32, NIT = I_IN + I_C + I_O + 2 * I_U + I_D;
    for (int it = gw; it < NIT; it += F.NGW) {
        int r = it;
        if (r < I_IN) { const int kb = r >> 8, nb = r & 255; p0_tr_item(F.w_in, IN_DIM, win_segbase(nb >> 2) + 32 * (nb & 3), F.WIN, D, 32 * nb, 64 * kb, scr, F.lane); continue; } r -= I_IN;
        if (r < I_C) { p0_tr_item(F.w_in, IN_DIM, C_CF, F.WC, D, 0, 64 * r, scr, F.lane); continue; } r -= I_C;
        if (r < I_O) { const int kb = r >> 5, nb = r & 31; p0_tr_item(F.w_out, D, 32 * nb, F.WOUT, D, 32 * nb, 64 * kb, scr, F.lane); continue; } r -= I_O;
        if (r < I_U) { const int kb = r / 88, nb = r % 88; p0_tr_item(F.w_up, FF, 32 * nb, F.WUG, D, 32 * nb, 64 * kb, scr, F.lane); continue; } r -= I_U;
        if (r < I_U) { const int kb = r / 88, nb = r % 88; p0_tr_item(F.w_gate, FF, 32 * nb, F.WUG, D, FF + 32 * nb, 64 * kb, scr, F.lane); continue; } r -= I_U;
        { const int kb = r >> 5, nb = r & 31; p0_tr_item(F.w_down, D, 32 * nb, F.WDN, FF, 32 * nb, 64 * kb, scr, F.lane); }
    }
}

__device__ __forceinline__ void p2_inproj_mfma(Frame& F) {
    if (CODES_MFMA) p2_codes_mfma(F);
    else for (int i = F.gtid; i < M * 32; i += F.NT) { const int m = i >> 5, j = i & 31; F.CODES[i] = dot_bf16(F.BUFA + (size_t)m * D, F.WC + (size_t)j * D, D); }
    pg8::Gemm g{F.BUFA, F.WIN, M, NIN, D}; pg8::InProjOrder S; S.init(F.G, (int)blockIdx.x);
    pg8::EpiInProj E{F.QKV, F.PP, F.A1, F.B1};
    pg8::gemm_phase<pg8::EpiInProj, pg8::InProjOrder, true, true>(F.lds, g, S, E);
}
__device__ __forceinline__ void p4a_mfma(Frame& F) {
    pg8::Gemm g{F.BUFB, F.WOUT, M, D, D}; pg8::StaticOrder S; S.init(M, D, F.G, (int)blockIdx.x);
    pg8::EpiResid E{F.xp, F.xs, F.out, F.MOD + 2 * D};
    pg8::gemm_phase<pg8::EpiResid, pg8::StaticOrder, true, true>(F.lds, g, S, E);
}
__device__ __forceinline__ void p5_mfma(Frame& F) {
    pg8::Gemm g{F.BUFA, F.WUG, M, FF2, D}; pg8::StaticOrder S; S.init(M, FF2, F.G, (int)blockIdx.x);
    pg8::EpiBf16P E{F.UG, FF2};
    pg8::gemm_phase<pg8::EpiBf16P, pg8::StaticOrder, true, true>(F.lds, g, S, E);
}
__device__ __forceinline__ void p6a_mfma(Frame& F) {
    pg8::Gemm g{F.ACT, F.WDN, M, D, FF}; pg8::StaticOrder S; S.init(M, D, F.G, (int)blockIdx.x);
    pg8::EpiResid E{nullptr, nullptr, F.out, F.MOD + 5 * D};
    pg8::gemm_phase<pg8::EpiResid, pg8::StaticOrder, true, true>(F.lds, g, S, E);
}

struct Args { const float* in[24]; float* out; unsigned char* ws; int ph_lo, ph_hi; };
__global__ void __launch_bounds__(NTHR, 2) fwd_kernel(Args args) {
    __shared__ __attribute__((aligned(16))) unsigned char lds_raw[LDS_BYTES];
    Frame F;
    F.lds = (LAS unsigned char*)lds_raw;
    F.MISC = (volatile LAS unsigned*)(F.lds + MISC_OFF);
    F.tid = threadIdx.x; F.lane = F.tid & 63; F.wave = __builtin_amdgcn_readfirstlane(F.tid >> 6);
    F.G = gridDim.x; { const int bx = blockIdx.x; F.vcu = (F.G % 8 == 0) ? (bx % 8) * (F.G / 8) + bx / 8 : bx; }
    F.gtid = blockIdx.x * NTHR + F.tid; F.NT = F.G * NTHR; F.gw = blockIdx.x * NWAVES + F.wave; F.NGW = F.G * NWAVES;
    unsigned char* ws = args.ws;
    F.ctl = (gu32*)(ws + WS_CTL);
    F.xp = args.in[0]; F.xs = args.in[1]; F.c = args.in[2]; F.st_f = args.in[3]; F.st_b = args.in[4]; F.c_ctx = args.in[5]; F.w_ada = args.in[6]; F.b_ada = args.in[7];
    F.g1 = args.in[8]; F.w_in = args.in[9]; F.wgk_f = args.in[10]; F.bgk_f = args.in[11]; F.wgk_b = args.in[12]; F.bgk_b = args.in[13]; F.gla_g = args.in[14]; F.cmw = args.in[15];
    F.w_out = args.in[16]; F.g2 = args.in[17]; F.w_up = args.in[18]; F.w_gate = args.in[19]; F.fcw = args.in[20]; F.fcb = args.in[21]; F.w_down = args.in[22]; F.gf = args.in[23];
    F.out = args.out;
    F.MOD = (float*)(ws + WS_MOD); F.CODES = (float*)(ws + WS_CODES);
    F.WIN = (bf16*)(ws + WS_WIN); F.WC = (bf16*)(ws + WS_WC); F.WOUT = (bf16*)(ws + WS_WOUT); F.WUG = (bf16*)(ws + WS_WUG); F.WDN = (bf16*)(ws + WS_WDN);
    F.BUFA = (bf16*)(ws + WS_BUFA); F.BUFB = (bf16*)(ws + WS_BUFB); F.QKV = (bf16*)(ws + WS_QKV); F.PP = (bf16*)(ws + WS_PP); F.A1 = (bf16*)(ws + WS_A1); F.B1 = (bf16*)(ws + WS_B1);
    F.OF = (bf16*)(ws + WS_OF); F.OB = (bf16*)(ws + WS_OB); F.ACT = (bf16*)(ws + WS_ACT); F.UG = (bf16*)(ws + WS_UG);
    for (int u = F.tid; u < (LDS_BYTES - 131072) / 4; u += NTHR) ((LAS unsigned*)(F.lds + 131072))[u] = 0u;
    __syncthreads();
    XcdBarrier bar; bar.bar = (unsigned*)(F.ctl + CW_BAR); bar.x = 0; bar.st = nullptr;
    if (N_LAUNCHES != PER_PHASE) bar = xcd_barrier_post((unsigned*)(F.ctl + CW_BAR), F.MISC + 8);
#define GRID_BAR() do { if (N_LAUNCHES == PER_PHASE) { if (F.tid == 0) __hip_atomic_store(F.ctl + CW_TMO, 0xBADBA0u, RLX_AGENT); } else { xcd_barrier(bar); } } while (0)
    const int lo = args.ph_lo, hi = args.ph_hi;
#define IN(k) (lo <= (k) && (k) < hi)
#define BOTH(k) (IN(k) && IN((k) + 1))
    if (IN(0)) { p0_prologue(F); if (P0_FAST) p0_weights_fast(F); if (BOTH(0)) GRID_BAR(); }
    if (IN(1)) { p1_xn(F); if (BOTH(1)) GRID_BAR(); }
    if (IN(2)) { if (MFMA_P2) p2_inproj_mfma(F); else p2_inproj_naive(F); if (BOTH(2)) GRID_BAR(); }
    if (IN(3)) { if (GLA_MFMA) p3_gla_mfma(F); else p3_gla_naive(F); if (BOTH(3)) GRID_BAR(); }
    if (IN(4)) { p3b_mixprep(F); if (BOTH(4)) GRID_BAR(); }
    if (IN(5)) { if (MFMA_P4) p4a_mfma(F); else p4a_naive(F); if (BOTH(5)) GRID_BAR(); }
    if (IN(6)) { p4b_norm2(F); if (BOTH(6)) GRID_BAR(); }
    if (IN(7)) { if (MFMA_P5) p5_mfma(F); else p5_naive(F); if (BOTH(7)) GRID_BAR(); }
    if (IN(8)) { p5b_act(F); if (BOTH(8)) GRID_BAR(); }
    if (IN(9)) { if (MFMA_P6) p6a_mfma(F); else p6a_naive(F); if (BOTH(9)) GRID_BAR(); }
    if (IN(10)) { p6b_normf(F); }
#undef IN
#undef BOTH
}

extern "C" void kernel_launch(void* const* d_in, const int* in_sizes, int n_in, void* d_out, int out_size, void* d_ws, size_t ws_size, hipStream_t stream) {
    static int grid = 0;
    if (grid == 0) {
        if (n_in != 24 || in_sizes[0] != M_P * D || in_sizes[1] != M_S * D || out_size != M * D + 2 * 32 * NH * HK * HV || ws_size < WS_END) {
            fprintf(stderr, "kernel_launch: unexpected shapes: n_in %d in0 %d in1 %d out %d ws %zu; nothing launched\n", n_in, n_in > 0 ? in_sizes[0] : -1, n_in > 1 ? in_sizes[1] : -1, out_size, ws_size); grid = -1; return; }
        int dev = 0, cus = 0, per_cu = 0;
        if (hipGetDevice(&dev) != hipSuccess || hipDeviceGetAttribute(&cus, hipDeviceAttributeMultiprocessorCount, dev) != hipSuccess) { fprintf(stderr, "kernel_launch: device query failed\n"); grid = -1; return; }
        if (hipOccupancyMaxActiveBlocksPerMultiprocessor(&per_cu, (const void*)fwd_kernel, NTHR, 0) != hipSuccess || per_cu < 1) { fprintf(stderr, "kernel_launch: occupancy query says %d blocks per CU\n", per_cu); (void)hipGetLastError(); grid = -1; return; }
        grid = cus;
    }
    if (grid < 0) return;
    if (hipMemsetAsync((char*)d_ws + WS_CTL, 0, CTL_ZERO_BYTES, stream) != hipSuccess) { fprintf(stderr, "kernel_launch: memset failed\n"); return; }
    Args a{};
    for (int i = 0; i < 24; ++i) a.in[i] = (const float*)d_in[i];
    a.out = (float*)d_out; a.ws = (unsigned char*)d_ws;
    if (N_LAUNCHES == 1) { a.ph_lo = 0; a.ph_hi = PER_PHASE; hipLaunchKernelGGL(fwd_kernel, dim3(grid), dim3(NTHR), 0, stream, a); }
    else for (int li = 0; li < PER_PHASE; ++li) { a.ph_lo = li; a.ph_hi = li + 1; hipLaunchKernelGGL(fwd_kernel, dim3(grid), dim3(NTHR), 0, stream, a); }
}
```
